# Optimizing an MI355X kernel written in HIP

```python
import math
import jax, jax.numpy as jnp
from jax import lax
import numpy as np

D_MODEL = 1024
BATCH = 8
SEQ = 2048
DEPTH = 2
DEC_BATCH = 128
DEC_SEQ = 8
PAST_LEN = 16384
PAGE_SIZE = 128

D_MIX = D_MODEL
D_HALF = D_MIX // 2
LRU_HEADS = 8
LRU_HEAD_DIM = D_HALF // LRU_HEADS
LRU_CONV = 4
RG_C = 8.0
SC_CONV = 3
FFN_CONV = 3
D_FF = 2816
N_IN = 5 * D_HALF
EPS = 1e-6

kernel_name = "hybrid_rglru_shortconv_convffn_step"


def rmsnorm(x, g):
    xf = x.astype(jnp.float32)
    y = xf * lax.rsqrt(jnp.mean(xf * xf, axis=-1, keepdims=True) + EPS)
    return (y * g.astype(jnp.float32)).astype(x.dtype)


def causal_conv(x, buf, w):
    K = w.shape[0]
    T = x.shape[1]
    xp = jnp.concatenate([buf.astype(x.dtype), x], axis=1)
    y = xp[:, 0:T] * w[0]
    for k in range(1, K):
        y = y + xp[:, k:k + T] * w[k]
    return y, xp[:, T:]


def block_diag(x, w, b):
    B_, T_, _ = x.shape
    xh = x.reshape(B_, T_, LRU_HEADS, LRU_HEAD_DIM)
    y = jnp.einsum('bthi,hij->bthj', xh, w).reshape(B_, T_, D_HALF)
    return y + b


def rglru(x, r, i, lam, h0):
    xf = x.astype(jnp.float32)
    rf = r.astype(jnp.float32)
    if_ = i.astype(jnp.float32)
    log_a = -RG_C * rf * jax.nn.softplus(-lam.astype(jnp.float32))
    a = jnp.exp(log_a)
    mult = jnp.sqrt(-jnp.expm1(2.0 * log_a))
    b = mult * (if_ * xf)
    b = b.at[:, 0].add(a[:, 0] * h0.astype(jnp.float32))

    def comb(left, right):
        a1, b1 = left
        a2, b2 = right
        return a1 * a2, a2 * b1 + b2

    _, h = lax.associative_scan(comb, (a, b), axis=1)
    return h.astype(x.dtype), h[:, -1].astype(h0.dtype)


def layer(x, c, st_h, st_lc, st_sc, st_fc,
          w_ada, b_ada, norm1_g, norm2_g, w_in, lru_conv_w, lru_conv_b,
          lru_wa, lru_ba, lru_wx, lru_bx, lru_lambda, sc_conv_w, w_out,
          ffn_w_up, ffn_conv_w, ffn_w_down):
    mod = (jax.nn.silu(c) @ w_ada + b_ada)[:, None, :]
    sh1, sc1, g1, sh2, sc2, g2 = jnp.split(mod, 6, axis=-1)

    hn = rmsnorm(x, norm1_g) * (1.0 + sc1) + sh1
    proj = hn @ w_in
    xl, gl, bs, cs, hs = jnp.split(proj, 5, axis=-1)
    xc, new_lc = causal_conv(xl, st_lc, lru_conv_w)
    xc = xc + lru_conv_b
    r = jax.nn.sigmoid(block_diag(xc, lru_wa, lru_ba))
    ig = jax.nn.sigmoid(block_diag(xc, lru_wx, lru_bx))
    h_seq, h_last = rglru(xc, r, ig, lru_lambda, st_h)
    lru_out = h_seq * jax.nn.gelu(gl)
    zc, new_sc = causal_conv(cs * hs, st_sc, sc_conv_w)
    sc_out = bs * zc
    mix = jnp.concatenate([lru_out, sc_out], axis=-1) @ w_out
    x = x + g1 * mix

    hn2 = rmsnorm(x, norm2_g) * (1.0 + sc2) + sh2
    u, v = jnp.split(hn2 @ ffn_w_up, 2, axis=-1)
    uc, new_fc = causal_conv(u, st_fc, ffn_conv_w)
    x = x + g2 * ((jax.nn.gelu(uc) * v) @ ffn_w_down)
    return x, h_last, new_lc, new_sc, new_fc


def run_trunk(x, c, st_h, st_lc, st_sc, st_fc, w_ada, b_ada, norm1_g, norm2_g,
              w_in, lru_conv_w, lru_conv_b, lru_wa, lru_ba, lru_wx, lru_bx,
              lru_lambda, sc_conv_w, w_out, ffn_w_up, ffn_conv_w, ffn_w_down,
              final_g):
    hs, lcs, scs, fcs = [], [], [], []
    for l in range(DEPTH):
        x, h, lc, sc, fc = layer(
            x, c, st_h[l], st_lc[l], st_sc[l], st_fc[l],
            w_ada[l], b_ada[l], norm1_g[l], norm2_g[l], w_in[l], lru_conv_w[l],
            lru_conv_b[l], lru_wa[l], lru_ba[l], lru_wx[l], lru_bx[l],
            lru_lambda[l], sc_conv_w[l], w_out[l], ffn_w_up[l], ffn_conv_w[l],
            ffn_w_down[l])
        hs.append(h); lcs.append(lc); scs.append(sc); fcs.append(fc)
    y = rmsnorm(x, final_g)
    return y, jnp.stack(hs), jnp.stack(lcs), jnp.stack(scs), jnp.stack(fcs)


def setup_inputs(seed: int = 0) -> dict:
    key = jax.random.key(seed)
    ks = iter(jax.random.split(key, 40))
    nrm = lambda shape, s: jax.random.normal(next(ks), shape, jnp.float32) * s
    d = {}
    d["x_prompt"] = nrm((BATCH, SEQ, D_MODEL), 1.0)
    d["x_sample"] = nrm((DEC_BATCH, DEC_SEQ, D_MODEL), 1.0)
    d["c_prompt"] = nrm((BATCH, D_MODEL), 1.0)
    d["c_sample"] = nrm((DEC_BATCH, D_MODEL), 1.0)
    d["state_lru_h"] = nrm((DEPTH, DEC_BATCH, D_HALF), 0.5)
    d["state_lru_conv"] = nrm((DEPTH, DEC_BATCH, LRU_CONV - 1, D_HALF), 0.5)
    d["state_sc_conv"] = nrm((DEPTH, DEC_BATCH, SC_CONV - 1, D_HALF), 0.5)
    d["state_ffn_conv"] = nrm((DEPTH, DEC_BATCH, FFN_CONV - 1, D_FF), 0.5)
    d["w_ada"] = nrm((DEPTH, D_MODEL, 6 * D_MODEL), 0.5 * D_MODEL ** -0.5)
    d["b_ada"] = nrm((DEPTH, 6 * D_MODEL), 0.01)
    d["norm1_g"] = 1.0 + nrm((DEPTH, D_MODEL), 0.01)
    d["norm2_g"] = 1.0 + nrm((DEPTH, D_MODEL), 0.01)
    d["w_in"] = nrm((DEPTH, D_MODEL, N_IN), D_MODEL ** -0.5)
    d["lru_conv_w"] = nrm((DEPTH, LRU_CONV, D_HALF), LRU_CONV ** -0.5)
    d["lru_conv_b"] = nrm((DEPTH, D_HALF), 0.01)
    d["lru_wa"] = nrm((DEPTH, LRU_HEADS, LRU_HEAD_DIM, LRU_HEAD_DIM), LRU_HEAD_DIM ** -0.5)
    d["lru_ba"] = nrm((DEPTH, D_HALF), 0.01)
    d["lru_wx"] = nrm((DEPTH, LRU_HEADS, LRU_HEAD_DIM, LRU_HEAD_DIM), LRU_HEAD_DIM ** -0.5)
    d["lru_bx"] = nrm((DEPTH, D_HALF), 0.01)
    u = jax.random.uniform(next(ks), (DEPTH, D_HALF), jnp.float32, 0.9, 0.999)
    a0 = u ** (1.0 / RG_C)
    d["lru_lambda"] = jnp.log(a0) - jnp.log1p(-a0)
    d["sc_conv_w"] = nrm((DEPTH, SC_CONV, D_HALF), SC_CONV ** -0.5)
    d["w_out"] = nrm((DEPTH, D_MIX, D_MODEL), D_MIX ** -0.5)
    d["ffn_w_up"] = nrm((DEPTH, D_MODEL, 2 * D_FF), D_MODEL ** -0.5)
    d["ffn_conv_w"] = nrm((DEPTH, FFN_CONV, D_FF), FFN_CONV ** -0.5)
    d["ffn_w_down"] = nrm((DEPTH, D_FF, D_MODEL), D_FF ** -0.5)
    d["final_g"] = 1.0 + nrm((D_MODEL,), 0.01)
    return d


def reference(x_prompt, x_sample, c_prompt, c_sample, state_lru_h, state_lru_conv,
              state_sc_conv, state_ffn_conv, w_ada, b_ada, norm1_g, norm2_g, w_in,
              lru_conv_w, lru_conv_b, lru_wa, lru_ba, lru_wx, lru_bx, lru_lambda,
              sc_conv_w, w_out, ffn_w_up, ffn_conv_w, ffn_w_down, final_g):
    dt = x_prompt.dtype
    p_h = jnp.zeros((DEPTH, BATCH, D_HALF), dt)
    p_lc = jnp.zeros((DEPTH, BATCH, LRU_CONV - 1, D_HALF), dt)
    p_sc = jnp.zeros((DEPTH, BATCH, SC_CONV - 1, D_HALF), dt)
    p_fc = jnp.zeros((DEPTH, BATCH, FFN_CONV - 1, D_FF), dt)
    y_prompt, nh_p, nlc_p, nsc_p, nfc_p = run_trunk(
        x_prompt, c_prompt, p_h, p_lc, p_sc, p_fc, w_ada, b_ada, norm1_g, norm2_g,
        w_in, lru_conv_w, lru_conv_b, lru_wa, lru_ba, lru_wx, lru_bx, lru_lambda,
        sc_conv_w, w_out, ffn_w_up, ffn_conv_w, ffn_w_down, final_g)
    y_sample, nh_s, nlc_s, nsc_s, nfc_s = run_trunk(
        x_sample, c_sample, state_lru_h, state_lru_conv, state_sc_conv,
        state_ffn_conv, w_ada, b_ada, norm1_g, norm2_g, w_in, lru_conv_w,
        lru_conv_b, lru_wa, lru_ba, lru_wx, lru_bx, lru_lambda, sc_conv_w, w_out,
        ffn_w_up, ffn_conv_w, ffn_w_down, final_g)
    return (y_prompt, y_sample, nh_p, nlc_p, nsc_p, nfc_p, nh_s, nlc_s, nsc_s, nfc_s)
```

```cpp
#include <hip/hip_runtime.h>
#include <hip/hip_cooperative_groups.h>
#include <cstdio>
#include <cstdint>
namespace cg = cooperative_groups;

#define LAS __attribute__((address_space(3)))
typedef unsigned short bf16_t;
typedef short bf16x8 __attribute__((ext_vector_type(8)));
typedef float f32x4 __attribute__((ext_vector_type(4)));
typedef unsigned u32x4 __attribute__((ext_vector_type(4)));
typedef unsigned u32x2 __attribute__((ext_vector_type(2)));

constexpr int D = 1024, DH = 512, NIN = 2560, DFF = 2816, NUP = 5632;
constexpr int MP = 16384, MS = 1024, MT = 17408, NBATCH = 136, NMOD = 6144;
#ifndef N_LAUNCH_SPLIT
#define N_LAUNCH_SPLIT 1
#endif
constexpr int NPHASE = 26;
#ifndef PMASK
#define PMASK 127
#endif

enum { I_XP = 0, I_XS, I_CP, I_CS, I_SH, I_SLC, I_SSC, I_SFC, I_WADA, I_BADA, I_N1G, I_N2G, I_WIN, I_LCW, I_LCB, I_WA, I_BA, I_WX, I_BX, I_LAM, I_SCW, I_WOUT, I_WUP, I_FCW, I_WDN, I_FG };
constexpr size_t O_Y = 0, O_NH_P = 17825792, O_NLC_P = 17833984, O_NSC_P = 17858560, O_NFC_P = 17874944, O_NH_S = 17965056, O_NLC_S = 18096128, O_NSC_S = 18489344, O_NFC_S = 18751488, O_END = 20193280;
constexpr size_t LAYER_WT = 12320768, WT_IN = 0, WT_OUT = 2621440, WT_UP = 3670016, WT_DN = 9437184;
constexpr size_t WS_WT = 0, WS_MOD = 49283072, WS_AGG = WS_MOD + 6684672, WS_HN = WS_AGG + 1114112, WS_R1 = WS_HN + 35651584;
constexpr size_t WS_PROJ = WS_R1, WS_UB = WS_R1 + 89128960, WS_VB = WS_UB + 17825792;
constexpr size_t WS_UV = WS_R1, WS_ACT = WS_R1 + 103809024, WS_END = WS_ACT + 51904512;
constexpr int LDS_BYTES = 131072;

struct Params { const float* in[26]; float* out; unsigned char* ws; int ph_lo, ph_hi; };
#define CAS __attribute__((address_space(4)))
typedef const CAS Params* PP;

__device__ __forceinline__ unsigned cvt_pk_bf16(float lo, float hi) { unsigned r; asm volatile("v_cvt_pk_bf16_f32 %0, %1, %2" : "=v"(r) : "v"(lo), "v"(hi)); return r; }
__device__ __forceinline__ bf16_t f2bf(float f) { return (bf16_t)(cvt_pk_bf16(f, 0.f) & 0xffffu); }
__device__ __forceinline__ float bf_lo(unsigned w) { return __uint_as_float(w << 16); }
__device__ __forceinline__ float bf_hi(unsigned w) { return __uint_as_float(w & 0xffff0000u); }
__device__ __forceinline__ float bf2f(bf16_t b) { return __uint_as_float(((unsigned)b) << 16); }
__device__ __forceinline__ void unpack8(u32x4 w, float (&f)[8]) { f[0] = bf_lo(w.x); f[1] = bf_hi(w.x); f[2] = bf_lo(w.y); f[3] = bf_hi(w.y); f[4] = bf_lo(w.z); f[5] = bf_hi(w.z); f[6] = bf_lo(w.w); f[7] = bf_hi(w.w); }
__device__ __forceinline__ u32x4 pack8(const float (&f)[8]) { u32x4 w; w.x = cvt_pk_bf16(f[0], f[1]); w.y = cvt_pk_bf16(f[2], f[3]); w.z = cvt_pk_bf16(f[4], f[5]); w.w = cvt_pk_bf16(f[6], f[7]); return w; }
__device__ __forceinline__ bf16x8 as_bf16x8(u32x4 w) { return __builtin_bit_cast(bf16x8, w); }
__device__ __forceinline__ float sigmoidf_(float x) { return 1.0f / (1.0f + __expf(-x)); }
__device__ __forceinline__ float gelu_tanh(float x) { const float y = 1.5957691216057308f * (x + 0.044715f * x * x * x); return x / (1.0f + __expf(-y)); }
__device__ __forceinline__ float wave_sum(float v) {
#pragma unroll
    for (int o = 1; o < 64; o <<= 1) v += __shfl_xor(v, o);
    return v;
}
__device__ __forceinline__ int batch_of(int R) { return R < MP ? (R >> 11) : 8 + ((R - MP) >> 3); }
#define WAVE_LDS_SYNC() asm volatile("s_waitcnt lgkmcnt(0)" ::: "memory")

namespace pg8 {
constexpr int BM = 256, BK = 64, HALF = 128, HTB = HALF * BK * 2, STAGE_BYTES = 8 * HTB, NXCD = 8, WGM = 8;
__host__ __device__ __forceinline__ int lds_byte(int r, int c) { const int st = (r >> 4) * 2 + (c >> 5), rr = r & 15, cc = c & 31, ob = rr * 64 + cc * 2; return st * 1024 + (ob ^ (((ob >> 9) & 1) << 5)); }
__host__ __device__ __forceinline__ void stage_rc(int b, int& R, int& C) { const int st = b / 1024, sb = b % 1024, swz = sb ^ (((sb >> 9) & 1) << 5); R = (st >> 1) * 16 + swz / 64; C = (st & 1) * 32 + (swz % 64) / 2; }
__host__ __device__ __forceinline__ int perm32(int rho) { const int n = rho >> 4, i = rho & 15; return 8 * (i >> 2) + 4 * n + (i & 3); }
struct Unit { int pm, pn; };
struct Gemm { const bf16_t* A; const bf16_t* Bt; int M, N, K, lda, ldb; };
struct StaticOrder {
    int nM, nN, nwg, G, c;
    __device__ void init(int M, int N, int G_, int c_) { nM = M / BM; nN = N / BM; nwg = nM * nN; G = G_; c = c_; }
    __device__ bool next(int i, Unit& u) const {
        const long L = (long)i * G + c; if (L >= nwg) return false;
        int wgid = (int)L; { const int q = nwg / NXCD, r = nwg % NXCD, xcd = wgid % NXCD, off = wgid / NXCD; wgid = (xcd < r ? xcd * (q + 1) : r * (q + 1) + (xcd - r) * q) + off; }
        const int nig = WGM * nN, gid = wgid / nig, fm = gid * WGM, gsz = (nM - fm) < WGM ? (nM - fm) : WGM;
        u.pm = fm + ((wgid % nig) % gsz); u.pn = (wgid % nig) / gsz; return true;
    }
};

struct EpiBf16 {
    static constexpr bool PERM = true;
    bf16_t* O; int ldc;
    __device__ __forceinline__ void operator()(const f32x4 (&acc)[2][2][4][2], const Unit& u, int wr, int wc, int fr, int fq) const {
        const int row0 = u.pm * BM + wr * 64 + fr, col0 = u.pn * BM + wc * 32 + 8 * fq;
#pragma unroll
        for (int ai = 0; ai < 2; ++ai)
#pragma unroll
            for (int m = 0; m < 4; ++m) { bf16_t* rowp = O + (size_t)(row0 + ai * HALF + m * 16) * ldc + col0;
#pragma unroll
                for (int bj = 0; bj < 2; ++bj) { const f32x4 v0 = acc[ai][bj][m][0], v1 = acc[ai][bj][m][1];
                    u32x4 w; w.x = cvt_pk_bf16(v0[0], v0[1]); w.y = cvt_pk_bf16(v0[2], v0[3]); w.z = cvt_pk_bf16(v1[0], v1[1]); w.w = cvt_pk_bf16(v1[2], v1[3]);
                    *(u32x4*)(rowp + bj * HALF) = w; } }
    }
};
struct EpiRes {
    static constexpr bool PERM = false;
    const float* xp; const float* xs; float* X; const float* gate; int row_base;
    __device__ __forceinline__ void operator()(const f32x4 (&acc)[2][2][4][2], const Unit& u, int wr, int wc, int fr, int fq) const {
#pragma unroll
        for (int ai = 0; ai < 2; ++ai)
#pragma unroll
            for (int m = 0; m < 4; ++m) {
                const int R = row_base + u.pm * BM + ai * HALF + wr * 64 + m * 16 + fr;
                const float* xin = R < MP ? xp + (size_t)R * D : xs + (size_t)(R - MP) * D;
                const float* gp = gate + (size_t)batch_of(R) * NMOD;
                float* xo = X + (size_t)R * D;
#pragma unroll
                for (int bj = 0; bj < 2; ++bj)
#pragma unroll
                    for (int n = 0; n < 2; ++n) { const int c = u.pn * BM + bj * HALF + wc * 32 + n * 16 + 4 * fq;
                        const f32x4 xv = *(const f32x4*)(xin + c), gv = *(const f32x4*)(gp + c);
                        *(f32x4*)(xo + c) = xv + gv * acc[ai][bj][m][n]; }
            }
    }
};

template <class Epi>
__device__ __forceinline__ void gemm_phase(LAS unsigned char* lds, const Gemm g, const StaticOrder& S, const Epi& E, int tid_) {
    const int tid = tid_, wid = __builtin_amdgcn_readfirstlane(tid >> 6), lane = tid & 63, wr = wid >> 2, wc = wid & 3, fr = lane & 15, fq = lane >> 4;
    const int K = g.K, nt = K / BK;
    unsigned voffA[2], voffB[2];
#pragma unroll
    for (int i = 0; i < 2; ++i) { int R, C; stage_rc(tid * 16 + i * 8192, R, C); const int Rb = Epi::PERM ? ((R & ~31) + perm32(R & 31)) : R;
        voffA[i] = (unsigned)(R * g.lda + C) * 2u; voffB[i] = (unsigned)(Rb * g.ldb + C) * 2u; }
    const size_t kstep = (size_t)(BK * 2);
    const size_t hstepA = (size_t)HALF * g.lda * 2, hstepB = (size_t)HALF * g.ldb * 2;
    const size_t tstepA = 2 * hstepA, tstepB = 2 * hstepB;
    const unsigned ldsw = (unsigned)wid * 1024u;
    const int aoff = lds_byte(wr * 64 + fr, fq * 8), boff = lds_byte(wc * 32 + fr, fq * 8);
#define PG8_SA(b, h) (((b) * 2 + (h)) * HTB)
#define PG8_SB(b, h) ((4 + (b) * 2 + (h)) * HTB)
#define PG8_STAGE(bufoff, gbase, voff) do { _Pragma("unroll") for (int _i = 0; _i < 2; ++_i) \
        __builtin_amdgcn_global_load_lds((const unsigned*)((const char*)(gbase) + (voff)[_i]), (LAS unsigned*)(lds + (bufoff) + ldsw + _i * 8192), 16, 0, 0); } while (0)
#define PG8_LDA(dst, b, h) do { _Pragma("unroll") for (int m = 0; m < 4; ++m) _Pragma("unroll") for (int k = 0; k < 2; ++k) dst[m][k] = *(const LAS bf16x8*)(lds + PG8_SA(b, h) + aoff + m * 2048 + k * 1024); } while (0)
#define PG8_LDB(dst, b, h) do { _Pragma("unroll") for (int n = 0; n < 2; ++n) _Pragma("unroll") for (int k = 0; k < 2; ++k) dst[n][k] = *(const LAS bf16x8*)(lds + PG8_SB(b, h) + boff + n * 2048 + k * 1024); } while (0)
#define PG8_MMA(ai, bj, At, Bt) do { __builtin_amdgcn_s_setprio(1); _Pragma("unroll") for (int m = 0; m < 4; ++m) _Pragma("unroll") for (int n = 0; n < 2; ++n) _Pragma("unroll") for (int k = 0; k < 2; ++k) \
        acc[ai][bj][m][n] = __builtin_amdgcn_mfma_f32_16x16x32_bf16(Bt[n][k], At[m][k], acc[ai][bj][m][n], 0, 0, 0); __builtin_amdgcn_s_setprio(0); } while (0)
#define PG8_WAIT_V(n) asm volatile("s_waitcnt vmcnt(" #n ")" ::: "memory")
#define PG8_WAIT_L(n) asm volatile("s_waitcnt lgkmcnt(" #n ")" ::: "memory")
#define PG8_BAR __builtin_amdgcn_s_barrier()
#define PG8_SCHED __builtin_amdgcn_sched_barrier(0)
    Unit cur, nxt; int ui = 0;
    if (!S.next(0, cur)) return;
    f32x4 acc[2][2][4][2];
#pragma unroll
    for (int a = 0; a < 2; ++a)
#pragma unroll
        for (int b = 0; b < 2; ++b)
#pragma unroll
            for (int m = 0; m < 4; ++m)
#pragma unroll
                for (int n = 0; n < 2; ++n) acc[a][b][m][n] = (f32x4){0.f, 0.f, 0.f, 0.f};
    bf16x8 At[4][2], B0[2][2], B1[2][2];
    const char* cA = (const char*)g.A + (size_t)cur.pm * tstepA; const char* cB = (const char*)g.Bt + (size_t)cur.pn * tstepB;
    PG8_STAGE(PG8_SB(0, 0), cB, voffB); PG8_STAGE(PG8_SB(0, 1), cB + hstepB, voffB); PG8_STAGE(PG8_SA(0, 0), cA, voffA); PG8_STAGE(PG8_SA(0, 1), cA + hstepA, voffA);
    if (wr == 1) PG8_BAR;
    PG8_WAIT_V(2); PG8_BAR;
    PG8_STAGE(PG8_SB(1, 0), cB + kstep, voffB); PG8_STAGE(PG8_SA(1, 0), cA + kstep, voffA); PG8_STAGE(PG8_SB(1, 1), cB + hstepB + kstep, voffB);
    PG8_WAIT_V(6); PG8_BAR;
    for (;;) {
        const bool has_next = S.next(ui + 1, nxt);
        const char* nA = has_next ? (const char*)g.A + (size_t)nxt.pm * tstepA : cA; const char* nB = has_next ? (const char*)g.Bt + (size_t)nxt.pn * tstepB : cB;
        for (int t = 0; t < nt; t += 2) {
            const bool last = (t == nt - 2);
            const char* a1 = cA + (size_t)(t + 1) * kstep;
            const char* a2 = last ? nA : cA + (size_t)(t + 2) * kstep; const char* b2 = last ? nB : cB + (size_t)(t + 2) * kstep;
            const char* a3 = a2 + kstep; const char* b3 = b2 + kstep;
            PG8_LDB(B0, 0, 0); PG8_LDB(B1, 0, 1); PG8_SCHED; PG8_LDA(At, 0, 0); PG8_STAGE(PG8_SA(1, 1), a1 + hstepA, voffA);
            PG8_WAIT_V(8); PG8_WAIT_L(0); PG8_BAR; PG8_MMA(0, 0, At, B0); PG8_MMA(0, 1, At, B1); PG8_BAR; PG8_SCHED;
            PG8_LDA(At, 0, 1); PG8_STAGE(PG8_SB(0, 0), b2, voffB); PG8_STAGE(PG8_SB(0, 1), b2 + hstepB, voffB); PG8_STAGE(PG8_SA(0, 0), a2, voffA);
            PG8_WAIT_V(8); PG8_WAIT_L(0); PG8_BAR; PG8_MMA(1, 0, At, B0); PG8_MMA(1, 1, At, B1); PG8_BAR; PG8_SCHED;
            PG8_LDB(B0, 1, 0); PG8_LDB(B1, 1, 1); PG8_SCHED; PG8_LDA(At, 1, 0); PG8_STAGE(PG8_SA(0, 1), a2 + hstepA, voffA);
            PG8_WAIT_V(8); PG8_WAIT_L(0); PG8_BAR; PG8_MMA(0, 0, At, B0); PG8_MMA(0, 1, At, B1); PG8_BAR; PG8_SCHED;
            PG8_LDA(At, 1, 1); PG8_STAGE(PG8_SB(1, 0), b3, voffB); PG8_STAGE(PG8_SB(1, 1), b3 + hstepB, voffB); PG8_STAGE(PG8_SA(1, 0), a3, voffA);
            PG8_WAIT_V(8); PG8_WAIT_L(0); PG8_BAR; PG8_MMA(1, 0, At, B0); PG8_MMA(1, 1, At, B1); PG8_BAR; PG8_SCHED;
        }
        if (wr == 0) PG8_BAR;
        E(acc, cur, wr, wc, fr, fq);
        if (!has_next) break;
#pragma unroll
        for (int a = 0; a < 2; ++a)
#pragma unroll
            for (int b = 0; b < 2; ++b)
#pragma unroll
                for (int m = 0; m < 4; ++m)
#pragma unroll
                    for (int n = 0; n < 2; ++n) acc[a][b][m][n] = (f32x4){0.f, 0.f, 0.f, 0.f};
        cur = nxt; cA = nA; cB = nB; ++ui;
        if (wr == 1) PG8_BAR;
    }
    PG8_WAIT_V(0);
    PG8_BAR;
#undef PG8_SA
#undef PG8_SB
#undef PG8_STAGE
#undef PG8_LDA
#undef PG8_LDB
#undef PG8_MMA
#undef PG8_WAIT_V
#undef PG8_WAIT_L
#undef PG8_BAR
#undef PG8_SCHED
}
}

__device__ __forceinline__ void adaln_item(PP p, int it, unsigned char* shm, int tid_) {
    const int tid = tid_, lane = tid & 63, w = tid >> 6, fr = lane & 15, fq = lane >> 4;
    const int l = it / 96, cb = it % 96, n0 = cb * 64 + (w & 3) * 16, rh = w >> 2;
    bf16_t* SC = (bf16_t*)shm;
    const float* W = p->in[I_WADA] + (size_t)l * D * NMOD;
    const float* cP = p->in[I_CP]; const float* cS = p->in[I_CS];
    f32x4 acc[5];
#pragma unroll
    for (int i = 0; i < 5; ++i) acc[i] = (f32x4){0.f, 0.f, 0.f, 0.f};
    for (int kc = 0; kc < 4; ++kc) {
        __syncthreads();
        for (int idx = tid; idx < 144 * 256; idx += 512) { const int m = idx >> 8, kk = idx & 255; float v = 0.f;
            if (m < NBATCH) { const float* cr = m < 8 ? cP + m * D : cS + (m - 8) * D; const float x = cr[kc * 256 + kk]; v = x / (1.0f + __expf(-x)); }
            SC[m * 264 + kk] = f2bf(v); }
        __syncthreads();
#pragma unroll 2
        for (int ks = 0; ks < 8; ++ks) {
            const float* wp = W + (size_t)(kc * 256 + ks * 32 + fq * 8) * NMOD + n0 + fr;
            float wv[8];
#pragma unroll
            for (int j = 0; j < 8; ++j) wv[j] = wp[(size_t)j * NMOD];
            const bf16x8 wf = as_bf16x8(pack8(wv));
#pragma unroll
            for (int i = 0; i < 5; ++i) { const int mt = rh * 5 + i;
                if (mt < 9) { const bf16x8 af = *(const bf16x8*)(SC + (mt * 16 + fr) * 264 + ks * 32 + fq * 8); acc[i] = __builtin_amdgcn_mfma_f32_16x16x32_bf16(wf, af, acc[i], 0, 0, 0); } }
        }
    }
    float* MOD = (float*)(p->ws + WS_MOD);
    const float* bias = p->in[I_BADA] + l * NMOD;
#pragma unroll
    for (int i = 0; i < 5; ++i) { const int mt = rh * 5 + i, m = mt * 16 + fr;
        if (mt < 9 && m < NBATCH) { const int n = n0 + 4 * fq; const f32x4 bv = *(const f32x4*)(bias + n); *(f32x4*)(MOD + ((size_t)l * NBATCH + m) * NMOD + n) = acc[i] + bv; } }
}

__device__ __forceinline__ void convert_item(PP p, int r, unsigned char* shm, int tid_) {
    const int tid = tid_;
    const int l = r / 752; r %= 752;
    const float* W; int K, N; size_t wto;
    if (r < 160) { W = p->in[I_WIN] + (size_t)l * D * NIN; K = D; N = NIN; wto = WT_IN; }
    else if (r < 224) { r -= 160; W = p->in[I_WOUT] + (size_t)l * D * D; K = D; N = D; wto = WT_OUT; }
    else if (r < 576) { r -= 224; W = p->in[I_WUP] + (size_t)l * D * NUP; K = D; N = NUP; wto = WT_UP; }
    else { r -= 576; W = p->in[I_WDN] + (size_t)l * DFF * D; K = DFF; N = D; wto = WT_DN; }
    bf16_t* WT = (bf16_t*)(p->ws + WS_WT) + (size_t)l * LAYER_WT + wto;
    const int nb = N / 256, kb = r / nb, nbk = r % nb, k0 = kb * 64, n0 = nbk * 256;
    float* T = (float*)shm;
    __syncthreads();
#pragma unroll
    for (int i = 0; i < 8; ++i) { const int idx = i * 512 + tid, kk = idx >> 6, c4 = idx & 63;
        const f32x4 v = *(const f32x4*)(W + (size_t)(k0 + kk) * N + n0 + c4 * 4);
        float* t = T + kk * 257 + c4 * 4; t[0] = v[0]; t[1] = v[1]; t[2] = v[2]; t[3] = v[3]; }
    __syncthreads();
#pragma unroll
    for (int ps = 0; ps < 4; ++ps) { const int n = ps * 64 + (tid >> 3), kg = tid & 7; float f[8];
#pragma unroll
        for (int j = 0; j < 8; ++j) f[j] = T[(kg * 8 + j) * 257 + n];
        *(u32x4*)(WT + (size_t)(n0 + n) * K + k0 + kg * 8) = pack8(f); }
}

__device__ __forceinline__ void p0_phase(PP p, unsigned char* shm, int tid_, int bid_, int G_) {
    constexpr int N_ADA = 192, N_CV = 1504;
    for (int it = bid_; it < N_ADA + N_CV; it += G_) {
        if (it < N_ADA) adaln_item(p, it, shm, tid_); else convert_item(p, it - N_ADA, shm, tid_);
    }
}

template <bool FINAL>
__device__ __forceinline__ void norm_phase(const float* xp, const float* xs, const float* g, const float* mod, int sh_off, int sc_off, bf16_t* HN, float* Y, int tid_, int bid_, int G_) {
    const int lane = tid_ & 63, w = tid_ >> 6;
    const int gw = bid_ * 8 + w, NW = G_ * 8;
    for (int R = gw; R < MT; R += NW) {
        const float* xr = R < MP ? xp + (size_t)R * D : xs + (size_t)(R - MP) * D;
        f32x4 v[4]; float ss = 0.f;
#pragma unroll
        for (int j = 0; j < 4; ++j) { v[j] = *(const f32x4*)(xr + 4 * lane + 256 * j); ss += (v[j][0] * v[j][0] + v[j][1] * v[j][1]) + (v[j][2] * v[j][2] + v[j][3] * v[j][3]); }
        ss = wave_sum(ss);
        const float rstd = 1.0f / sqrtf(ss * (1.0f / D) + 1e-6f);
        if (FINAL) {
#pragma unroll
            for (int j = 0; j < 4; ++j) { const int c = 4 * lane + 256 * j; const f32x4 gg = *(const f32x4*)(g + c); *(f32x4*)(Y + (size_t)R * D + c) = v[j] * rstd * gg; }
        } else {
            const float* mb = mod + (size_t)batch_of(R) * NMOD;
#pragma unroll
            for (int j = 0; j < 4; ++j) { const int c = 4 * lane + 256 * j; const f32x4 gg = *(const f32x4*)(g + c), sc = *(const f32x4*)(mb + sc_off + c), sh = *(const f32x4*)(mb + sh_off + c);
                const f32x4 o = v[j] * rstd * gg * (sc + 1.0f) + sh;
                u32x2 wv; wv.x = cvt_pk_bf16(o[0], o[1]); wv.y = cvt_pk_bf16(o[2], o[3]);
                *(u32x2*)(HN + (size_t)R * D + c) = wv; }
        }
    }
}

constexpr int S1_CONST_BYTES = 11 * 512 * 4;
constexpr int S1_XCB = 0, S1_XCF = 2304, S1_BB = 2304 + 4352, S1_WREG = 2304 + 4352 + 4352;
__device__ __forceinline__ void s1_phase(PP p, int l, unsigned char* shm, int tid_, int bid_, int G_) {
    const int tid = tid_, lane = tid & 63, h = tid >> 6, fr = lane & 15, fq = lane >> 4;
    float* cst = (float*)shm;
    float* c_cw = cst, *c_cb = cst + 2048, *c_ba = cst + 2560, *c_bx = cst + 3072, *c_sp = cst + 3584, *c_scw = cst + 4096;
    __syncthreads();
    for (int i = tid; i < 2048; i += 512) c_cw[i] = p->in[I_LCW][l * 2048 + i];
    { const int i = tid; c_cb[i] = p->in[I_LCB][l * 512 + i]; c_ba[i] = p->in[I_BA][l * 512 + i]; c_bx[i] = p->in[I_BX][l * 512 + i];
      const float x = -p->in[I_LAM][l * 512 + i]; c_sp[i] = 8.0f * (fmaxf(x, 0.f) + log1pf(__expf(-fabsf(x)))); }
    for (int i = tid; i < 1536; i += 512) c_scw[i] = p->in[I_SCW][l * 1536 + i];
    __syncthreads();
    unsigned char* wreg = shm + S1_CONST_BYTES + h * S1_WREG;
    bf16_t* XCb = (bf16_t*)(wreg + S1_XCB);
    float* XCf = (float*)(wreg + S1_XCF);
    float* BBf = (float*)(wreg + S1_BB);
    bf16x8 wfa[4][2], wfx[4][2];
    {
        const float* Wa = p->in[I_WA] + ((size_t)l * 8 + h) * 4096; const float* Wx = p->in[I_WX] + ((size_t)l * 8 + h) * 4096;
#pragma unroll
        for (int nt = 0; nt < 4; ++nt)
#pragma unroll
            for (int ks = 0; ks < 2; ++ks) { float fa[8], fx[8];
#pragma unroll
                for (int j = 0; j < 8; ++j) { const int k = ks * 32 + fq * 8 + j, n = nt * 16 + fr; fa[j] = Wa[k * 64 + n]; fx[j] = Wx[k * 64 + n]; }
                wfa[nt][ks] = as_bf16x8(pack8(fa)); wfx[nt][ks] = as_bf16x8(pack8(fx)); }
    }
    const bf16_t* PROJ = (const bf16_t*)(p->ws + WS_PROJ);
    bf16_t* MIX = (bf16_t*)(p->ws + WS_HN);
    bf16_t* UB = (bf16_t*)(p->ws + WS_UB); bf16_t* VB = (bf16_t*)(p->ws + WS_VB);
    float* AGG = (float*)(p->ws + WS_AGG);
    const float* st_h = p->in[I_SH] + (size_t)l * 128 * DH;
    const float* st_lc = p->in[I_SLC] + (size_t)l * 128 * 3 * DH;
    const float* st_sc = p->in[I_SSC] + (size_t)l * 128 * 2 * DH;
    float* out = p->out;
    for (int ti = bid_; ti < MT / 64; ti += G_) {
        const bool smp = ti >= 256;
        float hcur = 0.f, Pcur = 1.f;
#pragma unroll 1
        for (int mt = 0; mt < 4; ++mt) {
            const int R0 = ti * 64 + mt * 16;
#pragma unroll 1
            for (int s = 0; s < 2; ++s) {
                const int row = s * 8 + (lane >> 3), R = R0 + row, cg8 = (lane & 7) * 8, c0 = h * 64 + cg8;
                int t, T, bsm = 0, bq;
                if (smp) { const int si = R - MP; bsm = si >> 3; t = si & 7; T = 8; bq = bsm; } else { t = R & 2047; T = 2048; bq = R >> 11; }
                float xc[8];
                { const f32x4 b0 = *(const f32x4*)(c_cb + c0), b1 = *(const f32x4*)(c_cb + c0 + 4); xc[0] = b0[0]; xc[1] = b0[1]; xc[2] = b0[2]; xc[3] = b0[3]; xc[4] = b1[0]; xc[5] = b1[1]; xc[6] = b1[2]; xc[7] = b1[3]; }
                float xl0[8];
#pragma unroll
                for (int k = 0; k < 4; ++k) {
                    const int tt = t - 3 + k; float xv[8];
                    if (tt >= 0) { unpack8(*(const u32x4*)(PROJ + (size_t)(R - 3 + k) * NIN + c0), xv); }
                    else if (smp) { const float* sp = st_lc + ((size_t)bsm * 3 + (3 + tt)) * DH + c0; const f32x4 a0 = *(const f32x4*)sp, a1 = *(const f32x4*)(sp + 4); xv[0] = a0[0]; xv[1] = a0[1]; xv[2] = a0[2]; xv[3] = a0[3]; xv[4] = a1[0]; xv[5] = a1[1]; xv[6] = a1[2]; xv[7] = a1[3]; }
                    else {
#pragma unroll
                        for (int j = 0; j < 8; ++j) xv[j] = 0.f; }
                    const f32x4 w0 = *(const f32x4*)(c_cw + k * 512 + c0), w1 = *(const f32x4*)(c_cw + k * 512 + c0 + 4);
                    xc[0] += w0[0] * xv[0]; xc[1] += w0[1] * xv[1]; xc[2] += w0[2] * xv[2]; xc[3] += w0[3] * xv[3]; xc[4] += w1[0] * xv[4]; xc[5] += w1[1] * xv[5]; xc[6] += w1[2] * xv[6]; xc[7] += w1[3] * xv[7];
                    if (k == 3) {
#pragma unroll
                        for (int j = 0; j < 8; ++j) xl0[j] = xv[j]; }
                }
                *(u32x4*)(XCb + row * 72 + cg8) = pack8(xc);
                *(f32x4*)(XCf + row * 68 + cg8) = (f32x4){xc[0], xc[1], xc[2], xc[3]}; *(f32x4*)(XCf + row * 68 + cg8 + 4) = (f32x4){xc[4], xc[5], xc[6], xc[7]};
                if (t >= T - 3) { float* o = out + (smp ? O_NLC_S : O_NLC_P) + (((size_t)l * (smp ? 128 : 8) + bq) * 3 + (t - (T - 3))) * DH + c0;
                    *(f32x4*)o = (f32x4){xl0[0], xl0[1], xl0[2], xl0[3]}; *(f32x4*)(o + 4) = (f32x4){xl0[4], xl0[5], xl0[6], xl0[7]}; }
                float zc[8], z2[8];
#pragma unroll
                for (int j = 0; j < 8; ++j) zc[j] = 0.f;
#pragma unroll
                for (int k = 0; k < 3; ++k) {
                    const int tt = t - 2 + k; float zv[8];
                    if (tt >= 0) { float cv[8], hv[8]; const bf16_t* pr = PROJ + (size_t)(R - 2 + k) * NIN + c0; unpack8(*(const u32x4*)(pr + 1536), cv); unpack8(*(const u32x4*)(pr + 2048), hv);
#pragma unroll
                        for (int j = 0; j < 8; ++j) zv[j] = cv[j] * hv[j]; }
                    else if (smp) { const float* sp = st_sc + ((size_t)bsm * 2 + (2 + tt)) * DH + c0; const f32x4 a0 = *(const f32x4*)sp, a1 = *(const f32x4*)(sp + 4); zv[0] = a0[0]; zv[1] = a0[1]; zv[2] = a0[2]; zv[3] = a0[3]; zv[4] = a1[0]; zv[5] = a1[1]; zv[6] = a1[2]; zv[7] = a1[3]; }
                    else {
#pragma unroll
                        for (int j = 0; j < 8; ++j) zv[j] = 0.f; }
                    const f32x4 w0 = *(const f32x4*)(c_scw + k * 512 + c0), w1 = *(const f32x4*)(c_scw + k * 512 + c0 + 4);
                    zc[0] += w0[0] * zv[0]; zc[1] += w0[1] * zv[1]; zc[2] += w0[2] * zv[2]; zc[3] += w0[3] * zv[3]; zc[4] += w1[0] * zv[4]; zc[5] += w1[1] * zv[5]; zc[6] += w1[2] * zv[6]; zc[7] += w1[3] * zv[7];
                    if (k == 2) {
#pragma unroll
                        for (int j = 0; j < 8; ++j) z2[j] = zv[j]; }
                }
                { float bv[8], so[8]; unpack8(*(const u32x4*)(PROJ + (size_t)R * NIN + 1024 + c0), bv);
#pragma unroll
                  for (int j = 0; j < 8; ++j) so[j] = bv[j] * zc[j];
                  *(u32x4*)(MIX + (size_t)R * D + 512 + c0) = pack8(so); }
                if (t >= T - 2) { float* o = out + (smp ? O_NSC_S : O_NSC_P) + (((size_t)l * (smp ? 128 : 8) + bq) * 2 + (t - (T - 2))) * DH + c0;
                    *(f32x4*)o = (f32x4){z2[0], z2[1], z2[2], z2[3]}; *(f32x4*)(o + 4) = (f32x4){z2[4], z2[5], z2[6], z2[7]}; }
            }
            WAVE_LDS_SYNC();
            f32x4 ga[4], gx[4];
            {
                const bf16x8 af0 = *(const bf16x8*)(XCb + fr * 72 + fq * 8), af1 = *(const bf16x8*)(XCb + fr * 72 + 32 + fq * 8);
#pragma unroll
                for (int nt = 0; nt < 4; ++nt) {
                    f32x4 a = (f32x4){0.f, 0.f, 0.f, 0.f}, x = (f32x4){0.f, 0.f, 0.f, 0.f};
                    a = __builtin_amdgcn_mfma_f32_16x16x32_bf16(wfa[nt][0], af0, a, 0, 0, 0); a = __builtin_amdgcn_mfma_f32_16x16x32_bf16(wfa[nt][1], af1, a, 0, 0, 0);
                    x = __builtin_amdgcn_mfma_f32_16x16x32_bf16(wfx[nt][0], af0, x, 0, 0, 0); x = __builtin_amdgcn_mfma_f32_16x16x32_bf16(wfx[nt][1], af1, x, 0, 0, 0);
                    ga[nt] = a; gx[nt] = x;
                }
            }
#pragma unroll
            for (int nt = 0; nt < 4; ++nt) {
                const int cl = nt * 16 + 4 * fq, cgl = h * 64 + cl;
                const f32x4 xv = *(const f32x4*)(XCf + fr * 68 + cl), ba = *(const f32x4*)(c_ba + cgl), bx = *(const f32x4*)(c_bx + cgl), sp = *(const f32x4*)(c_sp + cgl);
                f32x4 av, bv;
#pragma unroll
                for (int i = 0; i < 4; ++i) { const float r = sigmoidf_(ga[nt][i] + ba[i]), ig = sigmoidf_(gx[nt][i] + bx[i]);
                    const float la = -sp[i] * r, a = __expf(la), mult = sqrtf(fmaxf(-expm1f(2.0f * la), 0.f));
                    av[i] = a; bv[i] = mult * ig * xv[i]; }
                *(f32x4*)(XCf + fr * 68 + cl) = av; *(f32x4*)(BBf + fr * 68 + cl) = bv;
            }
            WAVE_LDS_SYNC();
            {
                const int c = h * 64 + lane;
                float gv[16];
#pragma unroll
                for (int row = 0; row < 16; ++row) gv[row] = bf2f(PROJ[(size_t)(R0 + row) * NIN + 512 + c]);
#pragma unroll
                for (int row = 0; row < 16; ++row) {
                    const int R = R0 + row;
                    const float a = XCf[row * 68 + lane], b = BBf[row * 68 + lane], gg = gelu_tanh(gv[row]);
                    if (smp && (row & 7) == 0) hcur = st_h[(size_t)((R - MP) >> 3) * DH + c];
                    hcur = a * hcur + b; Pcur *= a;
                    if (smp) { MIX[(size_t)R * D + c] = f2bf(hcur * gg); if ((row & 7) == 7) out[O_NH_S + ((size_t)l * 128 + ((R - MP) >> 3)) * DH + c] = hcur; }
                    else { UB[(size_t)R * DH + c] = f2bf(hcur * gg); VB[(size_t)R * DH + c] = f2bf(Pcur * gg); }
                }
            }
            WAVE_LDS_SYNC();
        }
        if (!smp) { const int c = h * 64 + lane; AGG[((size_t)ti * 2 + 0) * DH + c] = Pcur; AGG[((size_t)ti * 2 + 1) * DH + c] = hcur; }
    }
}

__device__ __forceinline__ void s2_phase(PP p, int l, unsigned char* shm, int tid_, int bid_, int G_) {
    const int tid = tid_;
    float* hin = (float*)shm;
    const float* AGG = (const float*)(p->ws + WS_AGG);
    const bf16_t* UB = (const bf16_t*)(p->ws + WS_UB); const bf16_t* VB = (const bf16_t*)(p->ws + WS_VB);
    bf16_t* MIX = (bf16_t*)(p->ws + WS_HN);
    for (int ti = bid_; ti < 256; ti += G_) {
        const int b = ti >> 5, jn = ti & 31, c = tid;
        __syncthreads();
        float hh = 0.f;
        for (int jj = 0; jj < jn; ++jj) { const float P = AGG[((size_t)(b * 32 + jj) * 2 + 0) * DH + c], H = AGG[((size_t)(b * 32 + jj) * 2 + 1) * DH + c]; hh = P * hh + H; }
        hin[c] = hh;
        if (jn == 31) { const float P = AGG[((size_t)ti * 2 + 0) * DH + c], H = AGG[((size_t)ti * 2 + 1) * DH + c]; p->out[O_NH_P + ((size_t)l * 8 + b) * DH + c] = P * hh + H; }
        __syncthreads();
#pragma unroll 2
        for (int i = 0; i < 8; ++i) { const int idx = i * 512 + tid, row = idx >> 6, c0 = (idx & 63) * 8; const size_t R = (size_t)ti * 64 + row;
            float u[8], v[8], o[8]; unpack8(*(const u32x4*)(UB + R * DH + c0), u); unpack8(*(const u32x4*)(VB + R * DH + c0), v);
#pragma unroll
            for (int j = 0; j < 8; ++j) o[j] = u[j] + v[j] * hin[c0 + j];
            *(u32x4*)(MIX + R * D + c0) = pack8(o); }
    }
}

__device__ __forceinline__ void a1_phase(PP p, int l, int r0, int nrows, int tid_, int bid_, int G_) {
    const bf16_t* UV = (const bf16_t*)(p->ws + WS_UV); bf16_t* ACT = (bf16_t*)(p->ws + WS_ACT);
    const float* fcw = p->in[I_FCW] + (size_t)l * 3 * DFF;
    const float* st_fc = p->in[I_SFC] + (size_t)l * 128 * 2 * DFF;
    const int total = nrows * 352, nthr = G_ * 512;
    for (int idx = bid_ * 512 + tid_; idx < total; idx += nthr) {
        const int Rl = idx / 352, ch = idx - Rl * 352, col = ch * 8, R = r0 + Rl;
        const bool smp = R >= MP; int t, T, bsm = 0, bq;
        if (smp) { const int si = R - MP; bsm = si >> 3; t = si & 7; T = 8; bq = bsm; } else { t = R & 2047; T = 2048; bq = R >> 11; }
        float uc[8], u2[8];
#pragma unroll
        for (int j = 0; j < 8; ++j) uc[j] = 0.f;
#pragma unroll
        for (int k = 0; k < 3; ++k) {
            const int tt = t - 2 + k; float uv[8];
            if (tt >= 0) unpack8(*(const u32x4*)(UV + (size_t)(Rl - 2 + k) * NUP + col), uv);
            else if (smp) { const float* sp = st_fc + ((size_t)bsm * 2 + (2 + tt)) * DFF + col; const f32x4 a0 = *(const f32x4*)sp, a1 = *(const f32x4*)(sp + 4); uv[0] = a0[0]; uv[1] = a0[1]; uv[2] = a0[2]; uv[3] = a0[3]; uv[4] = a1[0]; uv[5] = a1[1]; uv[6] = a1[2]; uv[7] = a1[3]; }
            else {
#pragma unroll
                for (int j = 0; j < 8; ++j) uv[j] = 0.f; }
            const f32x4 w0 = *(const f32x4*)(fcw + k * DFF + col), w1 = *(const f32x4*)(fcw + k * DFF + col + 4);
            uc[0] += w0[0] * uv[0]; uc[1] += w0[1] * uv[1]; uc[2] += w0[2] * uv[2]; uc[3] += w0[3] * uv[3]; uc[4] += w1[0] * uv[4]; uc[5] += w1[1] * uv[5]; uc[6] += w1[2] * uv[6]; uc[7] += w1[3] * uv[7];
            if (k == 2) {
#pragma unroll
                for (int j = 0; j < 8; ++j) u2[j] = uv[j]; }
        }
        float vv[8], o[8]; unpack8(*(const u32x4*)(UV + (size_t)Rl * NUP + DFF + col), vv);
#pragma unroll
        for (int j = 0; j < 8; ++j) o[j] = gelu_tanh(uc[j]) * vv[j];
        *(u32x4*)(ACT + (size_t)Rl * DFF + col) = pack8(o);
        if (t >= T - 2) { float* op = p->out + (smp ? O_NFC_S : O_NFC_P) + (((size_t)l * (smp ? 128 : 8) + bq) * 2 + (t - (T - 2))) * DFF + col;
            *(f32x4*)op = (f32x4){u2[0], u2[1], u2[2], u2[3]}; *(f32x4*)(op + 4) = (f32x4){u2[4], u2[5], u2[6], u2[7]}; }
    }
}

__device__ __forceinline__ void run_phase(PP p, int ph, unsigned char* shm) {
    int tid_ = threadIdx.x, bid_ = blockIdx.x, G_ = gridDim.x;
    asm volatile("" : "+v"(tid_)); asm volatile("" : "+s"(bid_)); asm volatile("" : "+s"(G_));
    float* X = p->out;
    bf16_t* HN = (bf16_t*)(p->ws + WS_HN);
    const float* MODb = (const float*)(p->ws + WS_MOD);
    bf16_t* WTb = (bf16_t*)(p->ws + WS_WT);
    if (ph == 0) { if (PMASK & 1) p0_phase(p, shm, tid_, bid_, G_); return; }
    if (ph == NPHASE - 1) { if (PMASK & 2) norm_phase<true>(X, X + (size_t)MP * D, p->in[I_FG], nullptr, 0, 0, nullptr, X, tid_, bid_, G_); return; }
    const int q = ph - 1, l = q / 12, s = q % 12;
    const float* mod = MODb + (size_t)l * NBATCH * NMOD;
    bf16_t* WT = WTb + (size_t)l * LAYER_WT;
    const float* xp = l == 0 ? p->in[I_XP] : X; const float* xs = l == 0 ? p->in[I_XS] : X + (size_t)MP * D;
    const int hf = (s >= 9) ? 1 : 0, r0 = hf * 8192, nrows = hf ? (MT - 8192) : 8192;
    int kind;
    if (s == 0 || s == 5) kind = 0; else if (s == 1 || s == 6 || s == 9) kind = 1; else if (s == 4 || s == 8 || s == 11) kind = 2; else if (s == 2) kind = 3; else if (s == 3) kind = 4; else kind = 5;
    if (kind == 0) { if (PMASK & 2) {
        if (s == 0) norm_phase<false>(xp, xs, p->in[I_N1G] + l * D, mod, 0, 1024, HN, nullptr, tid_, bid_, G_);
        else norm_phase<false>(X, X + (size_t)MP * D, p->in[I_N2G] + l * D, mod, 3072, 4096, HN, nullptr, tid_, bid_, G_); }
    } else if (kind == 1) {
        pg8::Gemm g; pg8::EpiBf16 E;
        if (s == 1) { g.A = HN; g.Bt = WT + WT_IN; g.M = MT; g.N = NIN; g.K = D; g.lda = D; g.ldb = D; E.O = (bf16_t*)(p->ws + WS_PROJ); E.ldc = NIN; }
        else { g.A = HN + (size_t)r0 * D; g.Bt = WT + WT_UP; g.M = nrows; g.N = NUP; g.K = D; g.lda = D; g.ldb = D; E.O = (bf16_t*)(p->ws + WS_UV); E.ldc = NUP; }
        pg8::StaticOrder S; S.init(g.M, g.N, G_, bid_);
        if (PMASK & 4) pg8::gemm_phase<pg8::EpiBf16>((LAS unsigned char*)shm, g, S, E, tid_);
    } else if (kind == 2) {
        pg8::Gemm g; pg8::EpiRes E;
        if (s == 4) { g.A = HN; g.Bt = WT + WT_OUT; g.M = MT; g.N = D; g.K = D; g.lda = D; g.ldb = D; E.xp = xp; E.xs = xs; E.X = X; E.gate = mod + 2048; E.row_base = 0; }
        else { g.A = (const bf16_t*)(p->ws + WS_ACT); g.Bt = WT + WT_DN; g.M = nrows; g.N = D; g.K = DFF; g.lda = DFF; g.ldb = DFF; E.xp = X; E.xs = X + (size_t)MP * D; E.X = X; E.gate = mod + 5120; E.row_base = r0; }
        pg8::StaticOrder S; S.init(g.M, g.N, G_, bid_);
        if (PMASK & 8) pg8::gemm_phase<pg8::EpiRes>((LAS unsigned char*)shm, g, S, E, tid_);
    } else if (kind == 3) { if (PMASK & 16) s1_phase(p, l, shm, tid_, bid_, G_);
    } else if (kind == 4) { if (PMASK & 32) s2_phase(p, l, shm, tid_, bid_, G_);
    } else { if (PMASK & 64) a1_phase(p, l, r0, nrows, tid_, bid_, G_); }
}

__global__ __launch_bounds__(512, 2) void mega(Params p_unused) {
    extern __shared__ __attribute__((aligned(16))) unsigned char shm[];
    cg::grid_group grid = cg::this_grid();
    PP pp = (PP)__builtin_amdgcn_kernarg_segment_ptr();
    const int ph_lo = pp->ph_lo, ph_hi = pp->ph_hi;
    for (int ph = ph_lo; ph < ph_hi; ++ph) {
        asm volatile("" : "+s"(pp));
        run_phase(pp, ph, shm);
        if (ph + 1 < ph_hi) grid.sync();
    }
}

extern "C" void kernel_launch(void* const* d_in, const int* in_sizes, int n_in, void* d_out, int out_size, void* d_ws, size_t ws_size, hipStream_t stream) {
    static int grid = 0;
    if (grid == 0) {
        if (n_in != 26 || (size_t)out_size != O_END || ws_size < WS_END) { fprintf(stderr, "kernel_launch: unexpected sizes n_in %d out %d ws %zu (need %zu)\n", n_in, out_size, ws_size, (size_t)WS_END); grid = -1; return; }
        int dev = 0, cus = 0, per_cu = 0;
        hipGetDevice(&dev); hipDeviceGetAttribute(&cus, hipDeviceAttributeMultiprocessorCount, dev);
        if (hipFuncSetAttribute((const void*)mega, hipFuncAttributeMaxDynamicSharedMemorySize, LDS_BYTES) != hipSuccess) { fprintf(stderr, "kernel_launch: hipFuncSetAttribute failed\n"); grid = -1; return; }
        if (hipOccupancyMaxActiveBlocksPerMultiprocessor(&per_cu, (const void*)mega, 512, LDS_BYTES) != hipSuccess || per_cu < 1) { fprintf(stderr, "kernel_launch: occupancy query failed (%d)\n", per_cu); (void)hipGetLastError(); per_cu = 1; }
        grid = cus * 1;
        if (per_cu < 1) grid = -1;
    }
    if (grid < 0) return;
    Params p{};
    for (int i = 0; i < 26; ++i) p.in[i] = (const float*)d_in[i];
    p.out = (float*)d_out; p.ws = (unsigned char*)d_ws;
#if N_LAUNCH_SPLIT
    for (int ph = 0; ph < NPHASE; ++ph) {
        p.ph_lo = ph; p.ph_hi = ph + 1;
        void* args[] = {&p};
        hipError_t e = hipLaunchCooperativeKernel((const void*)mega, dim3(grid), dim3(512), args, LDS_BYTES, stream);
        if (e != hipSuccess) { fprintf(stderr, "cooperative launch failed: %s (grid %d)\n", hipGetErrorString(e), grid); break; }
    }
#else
    p.ph_lo = 0; p.ph_hi = NPHASE;
    void* args[] = {&p};
    hipError_t e = hipLaunchCooperativeKernel((const void*)mega, dim3(grid), dim3(512), args, LDS_BYTES, stream);
    if (e != hipSuccess) fprintf(stderr, "cooperative launch failed: %s (grid %d)\n", hipGetErrorString(e), grid);
#endif
}
```

```cpp
#include <hip/hip_runtime.h>
#include <hip/hip_cooperative_groups.h>
#include <cstdio>
#include <cstdint>
namespace cg = cooperative_groups;

#define LAS __attribute__((address_space(3)))
typedef unsigned short bf16_t;
typedef short bf16x8 __attribute__((ext_vector_type(8)));
typedef float f32x4 __attribute__((ext_vector_type(4)));
typedef unsigned u32x4 __attribute__((ext_vector_type(4)));
typedef unsigned u32x2 __attribute__((ext_vector_type(2)));

constexpr int D = 1024, DH = 512, NIN = 2560, DFF = 2816, NUP = 5632;
constexpr int MP = 16384, MS = 1024, MT = 17408, NBATCH = 136, NMOD = 6144;
#ifndef N_LAUNCH_SPLIT
#define N_LAUNCH_SPLIT 0
#endif
constexpr int NPHASE = 18;
constexpr int SP_OUT = 8, SP_DN = 11;
static_assert((D / 64) % SP_OUT == 0 && ((D / 64) / SP_OUT) % 2 == 0 && (DFF / 64) % SP_DN == 0 && ((DFF / 64) / SP_DN) % 2 == 0 && SP_OUT <= 11 && SP_DN <= 11, "split chunk sizes");
#define REP_PH -1
#define REP_N 0
#ifndef PMASK
#define PMASK 127
#endif

enum { I_XP = 0, I_XS, I_CP, I_CS, I_SH, I_SLC, I_SSC, I_SFC, I_WADA, I_BADA, I_N1G, I_N2G, I_WIN, I_LCW, I_LCB, I_WA, I_BA, I_WX, I_BX, I_LAM, I_SCW, I_WOUT, I_WUP, I_FCW, I_WDN, I_FG };
constexpr size_t O_Y = 0, O_NH_P = 17825792, O_NLC_P = 17833984, O_NSC_P = 17858560, O_NFC_P = 17874944, O_NH_S = 17965056, O_NLC_S = 18096128, O_NSC_S = 18489344, O_NFC_S = 18751488, O_END = 20193280;
constexpr size_t LAYER_WT = 12320768, WT_IN = 0, WT_OUT = 2621440, WT_UP = 3670016, WT_DN = 9437184;
constexpr size_t WS_WT = 0, WS_MOD = 49283072, WS_AGG = WS_MOD + 6684672, WS_HN = WS_AGG + 1114112, WS_R1 = WS_HN + 35651584;
constexpr size_t WS_PROJ = WS_R1, WS_VB = WS_R1 + 89128960;
constexpr size_t WS_ACT = WS_R1;
constexpr size_t WS_UH = WS_R1 + 106954752, WS_UF = WS_UH + 1531904, WS_PART = WS_UF + 3063808, WS_XB = WS_PART + 23068672, WS_END = WS_XB + 35651584;
constexpr int LDS_XCH = 131072, LDS_BARW = 153600, LDS_BYTES = 153600 + 64;
constexpr size_t WS_BAR = WS_END;

struct Params { const float* in[26]; float* out; unsigned char* ws; int ph_lo, ph_hi, rep_ph, rep_n; };
#define CAS __attribute__((address_space(4)))
typedef const CAS Params* PP;

__device__ __forceinline__ unsigned cvt_pk_bf16(float lo, float hi) { unsigned r; asm volatile("v_cvt_pk_bf16_f32 %0, %1, %2" : "=v"(r) : "v"(lo), "v"(hi)); return r; }
__device__ __forceinline__ bf16_t f2bf(float f) { return (bf16_t)(cvt_pk_bf16(f, 0.f) & 0xffffu); }
__device__ __forceinline__ float bf_lo(unsigned w) { return __uint_as_float(w << 16); }
__device__ __forceinline__ float bf_hi(unsigned w) { return __uint_as_float(w & 0xffff0000u); }
__device__ __forceinline__ float bf2f(bf16_t b) { return __uint_as_float(((unsigned)b) << 16); }
__device__ __forceinline__ void unpack8(u32x4 w, float (&f)[8]) { f[0] = bf_lo(w.x); f[1] = bf_hi(w.x); f[2] = bf_lo(w.y); f[3] = bf_hi(w.y); f[4] = bf_lo(w.z); f[5] = bf_hi(w.z); f[6] = bf_lo(w.w); f[7] = bf_hi(w.w); }
__device__ __forceinline__ u32x4 pack8(const float (&f)[8]) { u32x4 w; w.x = cvt_pk_bf16(f[0], f[1]); w.y = cvt_pk_bf16(f[2], f[3]); w.z = cvt_pk_bf16(f[4], f[5]); w.w = cvt_pk_bf16(f[6], f[7]); return w; }
__device__ __forceinline__ bf16x8 as_bf16x8(u32x4 w) { return __builtin_bit_cast(bf16x8, w); }
__device__ __forceinline__ float sigmoidf_(float x) { return __builtin_amdgcn_rcpf(1.0f + __expf(-x)); }
__device__ __forceinline__ float gelu_tanh(float x) { const float a = x * __builtin_fmaf(x * x, -0.10294323957f, -2.3022081979f); return x * __builtin_amdgcn_rcpf(1.0f + __builtin_amdgcn_exp2f(a)); }
__device__ __forceinline__ float wave_sum(float v) {
#pragma unroll
    for (int o = 1; o < 64; o <<= 1) v += __shfl_xor(v, o);
    return v;
}
__device__ __forceinline__ int batch_of(int R) { return R < MP ? (R >> 11) : 8 + ((R - MP) >> 3); }
#define WAVE_LDS_SYNC() asm volatile("s_waitcnt lgkmcnt(0)" ::: "memory")


#define XB_TMO      128
#define XB_XCNT(j)  (256  + 64 * (j))
#define XB_XSUB(j)  (1280 + 64 * (j))
#define XB_XGEN(j)  (2304 + 64 * (j))
#define XB_TOP      3328
#define XB_TOPGEN   3392
#define XCD_BAR_WORDS 3456
#define XB_SPIN_CAP (1u << 20)
__device__ __forceinline__ unsigned xb_ld(unsigned* p)              { return __hip_atomic_load(p, __ATOMIC_RELAXED, __HIP_MEMORY_SCOPE_AGENT); }
__device__ __forceinline__ unsigned xb_add(unsigned* p, unsigned v) { return __hip_atomic_fetch_add(p, v, __ATOMIC_RELAXED, __HIP_MEMORY_SCOPE_AGENT); }
__device__ __forceinline__ unsigned xb_xcc_id() { return (unsigned)__builtin_amdgcn_s_getreg((3 << 11) | 20) & 0xFu; }
#define XB_SPIN(cond, bar) do { unsigned _sp = 0; while (cond) { __builtin_amdgcn_s_sleep(1); \
    if ((++_sp & 255u) == 0u) { if (xb_ld(&(bar)[XB_TMO])) break; if (_sp > XB_SPIN_CAP) { atomicAdd(&(bar)[XB_TMO], 1u); break; } } } } while (0)
struct XcdBarrier { unsigned* bar; unsigned x; volatile LAS unsigned* st; };
__device__ __forceinline__ XcdBarrier xcd_barrier_post(unsigned* bar, volatile LAS unsigned* st) {
    XcdBarrier b; b.bar = bar; b.x = xb_xcc_id(); b.st = st;
    if (threadIdx.x == 0) (void)xb_add(&bar[XB_XCNT(b.x)], 1u);
    return b;
}
__device__ __forceinline__ void xcd_barrier_complete(unsigned* bar, unsigned x, unsigned& nloc, unsigned& nx) {
    const unsigned G = gridDim.x * gridDim.y * gridDim.z;
    unsigned sum, cnt, mine, sp = 0u;
    for (;;) {
        sum = 0u; cnt = 0u; mine = 0u;
#pragma unroll
        for (unsigned j = 0; j < 16; ++j) { const unsigned c = xb_ld(&bar[XB_XCNT(j)]); sum += c; cnt += (c > 0u) ? 1u : 0u; mine = (j == x) ? c : mine; }
        if (sum == G) break;
        __builtin_amdgcn_s_sleep(1);
        if ((++sp & 255u) == 0u) { if (xb_ld(&bar[XB_TMO])) break; if (sp > XB_SPIN_CAP) { atomicAdd(&bar[XB_TMO], 1u); break; } }
    }
    nloc = mine > 0u ? mine : 1u; nx = cnt > 0u ? cnt : 1u;
}
__device__ __forceinline__ void xcd_barrier(const XcdBarrier& b) {
    asm volatile("s_waitcnt vmcnt(0)" ::: "memory");
    __syncthreads();
    if (threadIdx.x == 0) {
        unsigned* bar = b.bar;
        __builtin_amdgcn_s_waitcnt(0);
        unsigned nloc = b.st[0], nx = b.st[1];
        if (nloc == 0u) { xcd_barrier_complete(bar, b.x, nloc, nx); b.st[0] = nloc; b.st[1] = nx; }
        const unsigned old = xb_add(&bar[XB_XSUB(b.x)], 1u);
        const unsigned gen = old / nloc;
        if (old + 1u == (gen + 1u) * nloc) {
            __builtin_amdgcn_fence(__ATOMIC_RELEASE, "agent");
            asm volatile("s_waitcnt vmcnt(0)" ::: "memory");
            const unsigned og = xb_add(&bar[XB_TOP], 1u);
            const unsigned tg = og / nx;
            if (og + 1u == (tg + 1u) * nx) xb_add(&bar[XB_TOPGEN], 1u);
            else XB_SPIN(xb_ld(&bar[XB_TOPGEN]) == tg, bar);
            __builtin_amdgcn_fence(__ATOMIC_ACQUIRE, "agent");
            xb_add(&bar[XB_XGEN(b.x)], 1u);
            asm volatile("s_waitcnt vmcnt(0)" ::: "memory");
        } else {
            XB_SPIN(xb_ld(&bar[XB_XGEN(b.x)]) == gen, bar);
            __builtin_amdgcn_fence(__ATOMIC_ACQUIRE, "agent");
            asm volatile("s_waitcnt vmcnt(0)" ::: "memory");
        }
    }
    __syncthreads();
}

namespace pg8 {
constexpr int BM = 256, BK = 64, HALF = 128, HTB = HALF * BK * 2, STAGE_BYTES = 8 * HTB, NXCD = 8, WGM = 8;
__host__ __device__ __forceinline__ int lds_byte(int r, int c) { const int st = (r >> 4) * 2 + (c >> 5), rr = r & 15, cc = c & 31, ob = rr * 64 + cc * 2; return st * 1024 + (ob ^ (((ob >> 9) & 1) << 5)); }
__host__ __device__ __forceinline__ void stage_rc(int b, int& R, int& C) { const int st = b / 1024, sb = b % 1024, swz = sb ^ (((sb >> 9) & 1) << 5); R = (st >> 1) * 16 + swz / 64; C = (st & 1) * 32 + (swz % 64) / 2; }
__host__ __device__ __forceinline__ int perm32(int rho) { const int n = rho >> 4, i = rho & 15; return 8 * (i >> 2) + 4 * n + (i & 3); }
struct Unit { int pm, pn, kt0, nk; };
struct Gemm { const bf16_t* A; const bf16_t* Bt; int M, N, K, lda, ldb; };
struct StaticOrder {
    int nM, nN, nwg, G, c, nMf, nfull, nsm, sp, nkt, nks;
    __device__ void init(int M, int N, int K, int G_, int c_, int split_sp) {
        nM = M / BM; nN = N / BM; nwg = nM * nN; G = G_; c = c_; nkt = K / BK; nMf = nM; nfull = nwg; nsm = 0; sp = 1; nks = nkt;
        if (split_sp > 1) { sp = split_sp; nks = nkt / sp; nMf = MP / BM; nfull = nMf * nN; nsm = (nM - nMf) * nN; }
    }
    __device__ void tile(int L, Unit& u) const {
        int wgid = L; { const int q = nfull / NXCD, r = nfull % NXCD, xcd = wgid % NXCD, off = wgid / NXCD; wgid = (xcd < r ? xcd * (q + 1) : r * (q + 1) + (xcd - r) * q) + off; }
        const int nig = WGM * nN, gid = wgid / nig, fm = gid * WGM, gsz = (nMf - fm) < WGM ? (nMf - fm) : WGM;
        u.pm = fm + ((wgid % nig) % gsz); u.pn = (wgid % nig) / gsz;
    }
    __device__ bool next(int i, Unit& u) const {
        const long L = (long)i * G + c;
        if (L < nfull) { tile((int)L, u); u.kt0 = 0; u.nk = nkt; return true; }
        const long j = L - nfull;
        if (j >= (long)nsm * sp) return false;
        const int jt = (int)(j / sp); u.pm = nMf + jt / nN; u.pn = jt % nN; u.kt0 = (int)(j % sp) * nks; u.nk = nks; return true;
    }
};

struct EpiBf16 {
    static constexpr bool PERM = true;
    bf16_t* O; int ldc;
    __device__ __forceinline__ void operator()(const f32x4 (&acc)[2][2][4][2], const Unit& u, int wr, int wc, int fr, int fq) const {
        const int row0 = u.pm * BM + wr * 64 + fr, col0 = u.pn * BM + wc * 32 + 8 * fq;
#pragma unroll
        for (int ai = 0; ai < 2; ++ai)
#pragma unroll
            for (int m = 0; m < 4; ++m) { bf16_t* rowp = O + (size_t)(row0 + ai * HALF + m * 16) * ldc + col0;
#pragma unroll
                for (int bj = 0; bj < 2; ++bj) { const f32x4 v0 = acc[ai][bj][m][0], v1 = acc[ai][bj][m][1];
                    u32x4 w; w.x = cvt_pk_bf16(v0[0], v0[1]); w.y = cvt_pk_bf16(v0[2], v0[3]); w.z = cvt_pk_bf16(v1[0], v1[1]); w.w = cvt_pk_bf16(v1[2], v1[3]);
                    *(u32x4*)(rowp + bj * HALF) = w; } }
    }
};
struct EpiRes {
    static constexpr bool PERM = true;
    const float* Xf; const bf16_t* Xin; bf16_t* X; const float* gate; bf16_t* part; int nkt; float scale;
    __device__ __forceinline__ void operator()(const f32x4 (&acc)[2][2][4][2], const Unit& u, int wr, int wc, int fr, int fq) const {
        const int Rt = u.pm * BM, c0 = u.pn * BM + wc * 32 + 8 * fq;
        if (u.nk != nkt) {
            bf16_t* pb = part + ((size_t)(u.kt0 / u.nk) * MS + (Rt - MP) + wr * 64 + fr) * D + c0;
#pragma unroll
            for (int ai = 0; ai < 2; ++ai)
#pragma unroll
                for (int m = 0; m < 4; ++m)
#pragma unroll
                    for (int bj = 0; bj < 2; ++bj) { const f32x4 v0 = acc[ai][bj][m][0], v1 = acc[ai][bj][m][1];
                        u32x4 w; w.x = cvt_pk_bf16(v0[0], v0[1]); w.y = cvt_pk_bf16(v0[2], v0[3]); w.z = cvt_pk_bf16(v1[0], v1[1]); w.w = cvt_pk_bf16(v1[2], v1[3]);
                        *(u32x4*)(pb + (size_t)(ai * HALF + m * 16) * D + bj * HALF) = w; }
        } else {
            const float* gp = gate + (size_t)(Rt >> 11) * NMOD + c0;
            f32x4 gv[2][2];
#pragma unroll
            for (int bj = 0; bj < 2; ++bj)
#pragma unroll
                for (int n = 0; n < 2; ++n) gv[bj][n] = *(const f32x4*)(gp + bj * HALF + n * 4) * scale;
            const size_t ro = (size_t)(Rt + wr * 64 + fr) * D + c0;
            bf16_t* xr = X + ro;
            if (Xf) {
                const float* xi = Xf + ro;
                f32x4 xa[2][2], xb[2][2];
#pragma unroll
                for (int bj = 0; bj < 2; ++bj)
#pragma unroll
                    for (int n = 0; n < 2; ++n) xa[bj][n] = *(const f32x4*)(xi + bj * HALF + n * 4);
#pragma unroll
                for (int grp = 0; grp < 8; ++grp) {
                    const int ai = grp >> 2, m = grp & 3;
                    if (grp + 1 < 8) { const float* xn = xi + (size_t)(((grp + 1) >> 2) * HALF + ((grp + 1) & 3) * 16) * D;
#pragma unroll
                        for (int bj = 0; bj < 2; ++bj)
#pragma unroll
                            for (int n = 0; n < 2; ++n) { if (grp & 1) xa[bj][n] = *(const f32x4*)(xn + bj * HALF + n * 4); else xb[bj][n] = *(const f32x4*)(xn + bj * HALF + n * 4); } }
                    bf16_t* xo = xr + (size_t)(ai * HALF + m * 16) * D;
#pragma unroll
                    for (int bj = 0; bj < 2; ++bj) { const f32x4 v0 = ((grp & 1) ? xb[bj][0] : xa[bj][0]) + gv[bj][0] * acc[ai][bj][m][0], v1 = ((grp & 1) ? xb[bj][1] : xa[bj][1]) + gv[bj][1] * acc[ai][bj][m][1];
                        u32x4 w; w.x = cvt_pk_bf16(v0[0], v0[1]); w.y = cvt_pk_bf16(v0[2], v0[3]); w.z = cvt_pk_bf16(v1[0], v1[1]); w.w = cvt_pk_bf16(v1[2], v1[3]);
                        *(u32x4*)(xo + bj * HALF) = w; }
                }
            } else {
                const bf16_t* xi = Xin + ro;
                u32x4 xa[2], xb[2];
#pragma unroll
                for (int bj = 0; bj < 2; ++bj) xa[bj] = *(const u32x4*)(xi + bj * HALF);
#pragma unroll
                for (int grp = 0; grp < 8; ++grp) {
                    const int ai = grp >> 2, m = grp & 3;
                    if (grp + 1 < 8) { const bf16_t* xn = xi + (size_t)(((grp + 1) >> 2) * HALF + ((grp + 1) & 3) * 16) * D;
#pragma unroll
                        for (int bj = 0; bj < 2; ++bj) { if (grp & 1) xa[bj] = *(const u32x4*)(xn + bj * HALF); else xb[bj] = *(const u32x4*)(xn + bj * HALF); } }
                    bf16_t* xo = xr + (size_t)(ai * HALF + m * 16) * D;
#pragma unroll
                    for (int bj = 0; bj < 2; ++bj) { const u32x4 xw = (grp & 1) ? xb[bj] : xa[bj];
                        const f32x4 x0 = (f32x4){bf_lo(xw.x), bf_hi(xw.x), bf_lo(xw.y), bf_hi(xw.y)}, x1 = (f32x4){bf_lo(xw.z), bf_hi(xw.z), bf_lo(xw.w), bf_hi(xw.w)};
                        const f32x4 v0 = x0 + gv[bj][0] * acc[ai][bj][m][0], v1 = x1 + gv[bj][1] * acc[ai][bj][m][1];
                        u32x4 w; w.x = cvt_pk_bf16(v0[0], v0[1]); w.y = cvt_pk_bf16(v0[2], v0[3]); w.z = cvt_pk_bf16(v1[0], v1[1]); w.w = cvt_pk_bf16(v1[2], v1[3]);
                        *(u32x4*)(xo + bj * HALF) = w; }
                }
            }
        }
    }
};

__device__ __forceinline__ float dpp_ror1(float v) { return __int_as_float(__builtin_amdgcn_mov_dpp(__float_as_int(v), 0x121, 0xf, 0xf, true)); }
__device__ __forceinline__ float dpp_ror2(float v) { return __int_as_float(__builtin_amdgcn_mov_dpp(__float_as_int(v), 0x122, 0xf, 0xf, true)); }
__device__ __forceinline__ float dpp_shr1_old(float old, float v) { return __int_as_float(__builtin_amdgcn_update_dpp(__float_as_int(old), __float_as_int(v), 0x111, 0xf, 0xf, false)); }
__device__ __forceinline__ float dpp_shr2_old(float old, float v) { return __int_as_float(__builtin_amdgcn_update_dpp(__float_as_int(old), __float_as_int(v), 0x112, 0xf, 0xf, false)); }
struct EpiFfn {
    static constexpr bool PERM = true;
    bf16_t* ACT; float* UH; float* UF; const float* fcw; const float* st_fc; float* nfc_p; float* nfc_s; LAS float* xch;
    __device__ __forceinline__ void operator()(const f32x4 (&acc)[2][2][4][2], const Unit& u, int wr, int wc, int fr, int fq) const {
        const int f0 = u.pn * 128 + wc * 32 + 8 * fq, Rt = u.pm * BM;
        float w0[8], w1[8], w2[8];
        { const f32x4 a0 = *(const f32x4*)(fcw + f0), a1 = *(const f32x4*)(fcw + f0 + 4), b0 = *(const f32x4*)(fcw + DFF + f0), b1 = *(const f32x4*)(fcw + DFF + f0 + 4), c0 = *(const f32x4*)(fcw + 2 * DFF + f0), c1 = *(const f32x4*)(fcw + 2 * DFF + f0 + 4);
#pragma unroll
          for (int j = 0; j < 4; ++j) { w0[j] = a0[j]; w0[j + 4] = a1[j]; w1[j] = b0[j]; w1[j + 4] = b1[j]; w2[j] = c0[j]; w2[j + 4] = c1[j]; } }
        __builtin_amdgcn_s_waitcnt(0x0F70);
        const unsigned xch_b = (unsigned)(uintptr_t)xch;
        if (Rt < MP) {
            if (fr >= 14) {
#pragma unroll
                for (int ai = 0; ai < 2; ++ai) { const unsigned d = xch_b + (unsigned)(((((ai * 2 + wr) * 4 + wc) * 2 + (fr - 14)) * 4 + fq) * 32);
                    asm volatile("ds_write_b128 %0, %1" :: "v"(d), "v"(acc[ai][0][3][0]) : "memory"); asm volatile("ds_write_b128 %0, %1 offset:16" :: "v"(d), "v"(acc[ai][0][3][1]) : "memory"); } }
            asm volatile("s_waitcnt lgkmcnt(0)" ::: "memory"); __builtin_amdgcn_s_barrier(); asm volatile("" ::: "memory");
#pragma unroll
            for (int ai = 0; ai < 2; ++ai) {
                float e14[8], e15[8];
                if (ai == 0 && wr == 0) {
#pragma unroll
                    for (int j = 0; j < 8; ++j) { e14[j] = 0.f; e15[j] = 0.f; }
                } else { const int pa = wr ? ai : 0, pw = wr ? 0 : 1; const unsigned sp = xch_b + (unsigned)(((((pa * 2 + pw) * 4 + wc) * 2 + 0) * 4 + fq) * 32);
                    f32x4 a0, a1, b0, b1;
                    asm volatile("ds_read_b128 %0, %1" : "=v"(a0) : "v"(sp) : "memory"); asm volatile("ds_read_b128 %0, %1 offset:16" : "=v"(a1) : "v"(sp) : "memory");
                    asm volatile("ds_read_b128 %0, %1 offset:128" : "=v"(b0) : "v"(sp) : "memory"); asm volatile("ds_read_b128 %0, %1 offset:144" : "=v"(b1) : "v"(sp) : "memory");
                    asm volatile("s_waitcnt lgkmcnt(0)" : "+v"(a0), "+v"(a1), "+v"(b0), "+v"(b1) :: "memory");
#pragma unroll
                    for (int j = 0; j < 4; ++j) { e14[j] = a0[j]; e14[j + 4] = a1[j]; e15[j] = b0[j]; e15[j + 4] = b1[j]; } }
#pragma unroll
                for (int m = 0; m < 4; ++m) {
                    float o[8];
#pragma unroll
                    for (int j = 0; j < 8; ++j) {
                        const float U = acc[ai][0][m][j >> 2][j & 3], V = acc[ai][1][m][j >> 2][j & 3];
                        float o1, o2;
                        if (m > 0) { const float Up = acc[ai][0][m > 0 ? m - 1 : 0][j >> 2][j & 3]; o1 = dpp_ror1(Up); o2 = dpp_ror2(Up); }
                        else { o1 = e15[j]; o2 = (fr == 0) ? e14[j] : e15[j]; }
                        const float p1 = dpp_shr1_old(o1, U), p2 = dpp_shr2_old(o2, U);
                        o[j] = gelu_tanh(w0[j] * p2 + w1[j] * p1 + w2[j] * U) * V;
                    }
                    *(u32x4*)(ACT + (size_t)(Rt + ai * HALF + wr * 64 + m * 16 + fr) * DFF + f0) = pack8(o);
                }
            }
            if (wr == 1 && fr >= 14) { float* d = UH + (size_t)(u.pm * 2 + (fr - 14)) * DFF + f0; *(f32x4*)d = acc[1][0][3][0]; *(f32x4*)(d + 4) = acc[1][0][3][1];
                if ((u.pm & 7) == 7) { float* q = nfc_p + (size_t)((u.pm >> 3) * 2 + (fr - 14)) * DFF + f0; *(f32x4*)q = acc[1][0][3][0]; *(f32x4*)(q + 4) = acc[1][0][3][1]; } }
            if (wr == 0 && fr < 2) { float* d = UF + (size_t)(u.pm * 2 + fr) * NUP + f0; *(f32x4*)d = acc[0][0][0][0]; *(f32x4*)(d + 4) = acc[0][0][0][1]; *(f32x4*)(d + DFF) = acc[0][1][0][0]; *(f32x4*)(d + DFF + 4) = acc[0][1][0][1]; }
        } else {
            const int t = fr & 7;
#pragma unroll
            for (int ai = 0; ai < 2; ++ai)
#pragma unroll
                for (int m = 0; m < 4; ++m) {
                    const int R = Rt + ai * HALF + wr * 64 + m * 16 + fr, b = (R - MP) >> 3;
                    float s0[8], s1[8];
#pragma unroll
                    for (int j = 0; j < 8; ++j) { s0[j] = 0.f; s1[j] = 0.f; }
                    if (t < 2) { const float* sp = st_fc + (size_t)b * 2 * DFF + f0; const f32x4 b0 = *(const f32x4*)(sp + DFF), b1 = *(const f32x4*)(sp + DFF + 4);
#pragma unroll
                        for (int j = 0; j < 4; ++j) { s1[j] = b0[j]; s1[j + 4] = b1[j]; }
                        if (t == 0) { const f32x4 a0 = *(const f32x4*)sp, a1 = *(const f32x4*)(sp + 4);
#pragma unroll
                            for (int j = 0; j < 4; ++j) { s0[j] = a0[j]; s0[j + 4] = a1[j]; } } }
                    float o[8];
#pragma unroll
                    for (int j = 0; j < 8; ++j) {
                        const float U = acc[ai][0][m][j >> 2][j & 3], V = acc[ai][1][m][j >> 2][j & 3];
                        const float r1 = dpp_ror1(U), r2 = dpp_ror2(U);
                        const float p1 = (t == 0) ? s1[j] : r1, p2 = (t == 0) ? s0[j] : ((t == 1) ? s1[j] : r2);
                        o[j] = gelu_tanh(w0[j] * p2 + w1[j] * p1 + w2[j] * U) * V;
                    }
                    *(u32x4*)(ACT + (size_t)R * DFF + f0) = pack8(o);
                    if (t >= 6) { float* q = nfc_s + (size_t)(b * 2 + (t - 6)) * DFF + f0; *(f32x4*)q = acc[ai][0][m][0]; *(f32x4*)(q + 4) = acc[ai][0][m][1]; }
                }
        }
    }
};

template <class Epi>
__device__ __forceinline__ void gemm_phase(LAS unsigned char* lds, const Gemm g, const StaticOrder& S, const Epi& E, int tid_) {
    const int tid = tid_, wid = __builtin_amdgcn_readfirstlane(tid >> 6), lane = tid & 63, wr = wid >> 2, wc = wid & 3, fr = lane & 15, fq = lane >> 4;
    unsigned voffA[2], voffB[2];
#pragma unroll
    for (int i = 0; i < 2; ++i) { int R, C; stage_rc(tid * 16 + i * 8192, R, C); const int Rb = Epi::PERM ? ((R & ~31) + perm32(R & 31)) : R;
        voffA[i] = (unsigned)(R * g.lda + C) * 2u; voffB[i] = (unsigned)(Rb * g.ldb + C) * 2u; }
    const size_t kstep = (size_t)(BK * 2);
    const size_t hstepA = (size_t)HALF * g.lda * 2, hstepB = (size_t)HALF * g.ldb * 2;
    const size_t tstepA = 2 * hstepA, tstepB = 2 * hstepB;
    const unsigned ldsw = (unsigned)wid * 1024u;
    const int aoff = lds_byte(wr * 64 + fr, fq * 8), boff = lds_byte(wc * 32 + fr, fq * 8);
#define PG8_SA(b, h) (((b) * 2 + (h)) * HTB)
#define PG8_SB(b, h) ((4 + (b) * 2 + (h)) * HTB)
#define PG8_STAGE(bufoff, gbase, voff) do { _Pragma("unroll") for (int _i = 0; _i < 2; ++_i) \
        __builtin_amdgcn_global_load_lds((const unsigned*)((const char*)(gbase) + (voff)[_i]), (LAS unsigned*)(lds + (bufoff) + ldsw + _i * 8192), 16, 0, 0); } while (0)
#define PG8_LDA(dst, b, h) do { _Pragma("unroll") for (int m = 0; m < 4; ++m) _Pragma("unroll") for (int k = 0; k < 2; ++k) dst[m][k] = *(const LAS bf16x8*)(lds + PG8_SA(b, h) + aoff + m * 2048 + k * 1024); } while (0)
#define PG8_LDB(dst, b, h) do { _Pragma("unroll") for (int n = 0; n < 2; ++n) _Pragma("unroll") for (int k = 0; k < 2; ++k) dst[n][k] = *(const LAS bf16x8*)(lds + PG8_SB(b, h) + boff + n * 2048 + k * 1024); } while (0)
#define PG8_MMA(ai, bj, At, Bt) do { __builtin_amdgcn_s_setprio(1); _Pragma("unroll") for (int m = 0; m < 4; ++m) _Pragma("unroll") for (int n = 0; n < 2; ++n) _Pragma("unroll") for (int k = 0; k < 2; ++k) \
        acc[ai][bj][m][n] = __builtin_amdgcn_mfma_f32_16x16x32_bf16(Bt[n][k], At[m][k], acc[ai][bj][m][n], 0, 0, 0); __builtin_amdgcn_s_setprio(0); } while (0)
#define PG8_WAIT_V(n) asm volatile("s_waitcnt vmcnt(" #n ")" ::: "memory")
#define PG8_WAIT_L(n) asm volatile("s_waitcnt lgkmcnt(" #n ")" ::: "memory")
#define PG8_BAR __builtin_amdgcn_s_barrier()
#define PG8_SCHED __builtin_amdgcn_sched_barrier(0)
    Unit cur, nxt; int ui = 0;
    if (!S.next(0, cur)) return;
    f32x4 acc[2][2][4][2];
#pragma unroll
    for (int a = 0; a < 2; ++a)
#pragma unroll
        for (int b = 0; b < 2; ++b)
#pragma unroll
            for (int m = 0; m < 4; ++m)
#pragma unroll
                for (int n = 0; n < 2; ++n) acc[a][b][m][n] = (f32x4){0.f, 0.f, 0.f, 0.f};
    bf16x8 At[4][2], B0[2][2], B1[2][2];
    const char* cA = (const char*)g.A + (size_t)cur.pm * tstepA + (size_t)cur.kt0 * kstep; const char* cB = (const char*)g.Bt + (size_t)cur.pn * tstepB + (size_t)cur.kt0 * kstep;
    PG8_STAGE(PG8_SB(0, 0), cB, voffB); PG8_STAGE(PG8_SB(0, 1), cB + hstepB, voffB); PG8_STAGE(PG8_SA(0, 0), cA, voffA); PG8_STAGE(PG8_SA(0, 1), cA + hstepA, voffA);
    if (wr == 1) PG8_BAR;
    PG8_WAIT_V(2); PG8_BAR;
    PG8_STAGE(PG8_SB(1, 0), cB + kstep, voffB); PG8_STAGE(PG8_SA(1, 0), cA + kstep, voffA); PG8_STAGE(PG8_SB(1, 1), cB + hstepB + kstep, voffB);
    PG8_WAIT_V(6); PG8_BAR;
    for (;;) {
        const bool has_next = S.next(ui + 1, nxt);
        const char* nA = has_next ? (const char*)g.A + (size_t)nxt.pm * tstepA + (size_t)nxt.kt0 * kstep : cA; const char* nB = has_next ? (const char*)g.Bt + (size_t)nxt.pn * tstepB + (size_t)nxt.kt0 * kstep : cB;
        const int nt = cur.nk;
        for (int t = 0; t < nt; t += 2) {
            const bool last = (t == nt - 2);
            const char* a1 = cA + (size_t)(t + 1) * kstep;
            const char* a2 = last ? nA : cA + (size_t)(t + 2) * kstep; const char* b2 = last ? nB : cB + (size_t)(t + 2) * kstep;
            const char* a3 = a2 + kstep; const char* b3 = b2 + kstep;
            PG8_LDB(B0, 0, 0); PG8_LDB(B1, 0, 1); PG8_SCHED; PG8_LDA(At, 0, 0); PG8_STAGE(PG8_SA(1, 1), a1 + hstepA, voffA);
            PG8_WAIT_V(8); PG8_WAIT_L(0); PG8_BAR; PG8_MMA(0, 0, At, B0); PG8_MMA(0, 1, At, B1); PG8_BAR; PG8_SCHED;
            PG8_LDA(At, 0, 1); PG8_STAGE(PG8_SB(0, 0), b2, voffB); PG8_STAGE(PG8_SB(0, 1), b2 + hstepB, voffB); PG8_STAGE(PG8_SA(0, 0), a2, voffA);
            PG8_WAIT_V(8); PG8_WAIT_L(0); PG8_BAR; PG8_MMA(1, 0, At, B0); PG8_MMA(1, 1, At, B1); PG8_BAR; PG8_SCHED;
            PG8_LDB(B0, 1, 0); PG8_LDB(B1, 1, 1); PG8_SCHED; PG8_LDA(At, 1, 0); PG8_STAGE(PG8_SA(0, 1), a2 + hstepA, voffA);
            PG8_WAIT_V(8); PG8_WAIT_L(0); PG8_BAR; PG8_MMA(0, 0, At, B0); PG8_MMA(0, 1, At, B1); PG8_BAR; PG8_SCHED;
            PG8_LDA(At, 1, 1); PG8_STAGE(PG8_SB(1, 0), b3, voffB); PG8_STAGE(PG8_SB(1, 1), b3 + hstepB, voffB); PG8_STAGE(PG8_SA(1, 0), a3, voffA);
            PG8_WAIT_V(8); PG8_WAIT_L(0); PG8_BAR; PG8_MMA(1, 0, At, B0); PG8_MMA(1, 1, At, B1); PG8_BAR; PG8_SCHED;
        }
        if (wr == 0) PG8_BAR;
        E(acc, cur, wr, wc, fr, fq);
        if (!has_next) break;
#pragma unroll
        for (int a = 0; a < 2; ++a)
#pragma unroll
            for (int b = 0; b < 2; ++b)
#pragma unroll
                for (int m = 0; m < 4; ++m)
#pragma unroll
                    for (int n = 0; n < 2; ++n) acc[a][b][m][n] = (f32x4){0.f, 0.f, 0.f, 0.f};
        cur = nxt; cA = nA; cB = nB; ++ui;
        if (wr == 1) PG8_BAR;
    }
    PG8_WAIT_V(0);
    PG8_BAR;
#undef PG8_SA
#undef PG8_SB
#undef PG8_STAGE
#undef PG8_LDA
#undef PG8_LDB
#undef PG8_MMA
#undef PG8_WAIT_V
#undef PG8_WAIT_L
#undef PG8_BAR
#undef PG8_SCHED
}
}

__device__ __forceinline__ void adaln_item(PP p, int it, unsigned char* shm, int tid_) {
    const int tid = tid_, lane = tid & 63, w = __builtin_amdgcn_readfirstlane(tid >> 6), fr = lane & 15, fq = lane >> 4;
    const int l = it / 96, cb = it % 96, n0 = cb * 64 + (w & 3) * 16, rh = w >> 2;
    bf16_t* SC = (bf16_t*)shm;
    const float* W = p->in[I_WADA] + (size_t)l * D * NMOD;
    const float* cP = p->in[I_CP]; const float* cS = p->in[I_CS];
    f32x4 acc[5];
#pragma unroll
    for (int i = 0; i < 5; ++i) acc[i] = (f32x4){0.f, 0.f, 0.f, 0.f};
    const int kk4 = (lane & 31) * 4, rsub = lane >> 5;
    const unsigned woff = (unsigned)(fq * 8 * NMOD + n0 + fr);
    float wv[2][4][8];
#define ADA_LOADW(buf, kc_) do { _Pragma("unroll") for (int ks = 0; ks < 4; ++ks) _Pragma("unroll") for (int j = 0; j < 8; ++j) { const float* wb = W + (size_t)((kc_) * 128 + ks * 32 + j) * NMOD; wv[buf][ks][j] = wb[woff]; } } while (0)
    ADA_LOADW(0, 0);
#pragma unroll
    for (int kc = 0; kc < 8; ++kc) {
        f32x4 cv[9];
#pragma unroll
        for (int ps = 0; ps < 9; ++ps) { const int m = ps * 16 + w * 2 + rsub;
            cv[ps] = (m < NBATCH) ? *(const f32x4*)((m < 8 ? cP + m * D : cS + (m - 8) * D) + kc * 128 + kk4) : (f32x4){0.f, 0.f, 0.f, 0.f}; }
        if (kc + 1 < 8) ADA_LOADW((kc + 1) & 1, kc + 1);
        __syncthreads();
#pragma unroll
        for (int ps = 0; ps < 9; ++ps) { const int m = ps * 16 + w * 2 + rsub; f32x4 x = cv[ps], y;
#pragma unroll
            for (int i = 0; i < 4; ++i) y[i] = x[i] * __builtin_amdgcn_rcpf(1.0f + __expf(-x[i]));
            u32x2 pk; pk.x = cvt_pk_bf16(y[0], y[1]); pk.y = cvt_pk_bf16(y[2], y[3]);
            *(u32x2*)(SC + m * 136 + kk4) = pk; }
        __syncthreads();
#pragma unroll
        for (int ks = 0; ks < 4; ++ks) {
            const bf16x8 wf = as_bf16x8(pack8(wv[kc & 1][ks]));
#pragma unroll
            for (int i = 0; i < 5; ++i) { const int mt = rh * 5 + i;
                if (mt < 9) { const bf16x8 af = *(const bf16x8*)(SC + (mt * 16 + fr) * 136 + ks * 32 + fq * 8); acc[i] = __builtin_amdgcn_mfma_f32_16x16x32_bf16(wf, af, acc[i], 0, 0, 0); } }
        }
    }
#undef ADA_LOADW
    float* MOD = (float*)(p->ws + WS_MOD);
    const float* bias = p->in[I_BADA] + l * NMOD;
#pragma unroll
    for (int i = 0; i < 5; ++i) { const int mt = rh * 5 + i, m = mt * 16 + fr;
        if (mt < 9 && m < NBATCH) { const int n = n0 + 4 * fq; const f32x4 bv = *(const f32x4*)(bias + n); *(f32x4*)(MOD + ((size_t)l * NBATCH + m) * NMOD + n) = acc[i] + bv; } }
}

__device__ __forceinline__ void convert_item(PP p, int r, unsigned char* shm, int tid_) {
    const int tid = tid_;
    const int l = r / 752; r %= 752;
    const float* W; int K, N; size_t wto; bool uvperm = false;
    if (r < 160) { W = p->in[I_WIN] + (size_t)l * D * NIN; K = D; N = NIN; wto = WT_IN; }
    else if (r < 224) { r -= 160; W = p->in[I_WOUT] + (size_t)l * D * D; K = D; N = D; wto = WT_OUT; }
    else if (r < 576) { r -= 224; W = p->in[I_WUP] + (size_t)l * D * NUP; K = D; N = NUP; wto = WT_UP; uvperm = true; }
    else { r -= 576; W = p->in[I_WDN] + (size_t)l * DFF * D; K = DFF; N = D; wto = WT_DN; }
    bf16_t* WT = (bf16_t*)(p->ws + WS_WT) + (size_t)l * LAYER_WT + wto;
    const int nb = N / 256, kb = r / nb, nbk = r % nb, k0 = kb * 64, n0 = nbk * 256;
    float* T = (float*)shm;
    __syncthreads();
#pragma unroll
    for (int i = 0; i < 8; ++i) { const int idx = i * 512 + tid, kk = idx >> 6, c4 = idx & 63;
        const f32x4 v = *(const f32x4*)(W + (size_t)(k0 + kk) * N + n0 + c4 * 4);
        float* t = T + kk * 257 + c4 * 4; t[0] = v[0]; t[1] = v[1]; t[2] = v[2]; t[3] = v[3]; }
    __syncthreads();
#pragma unroll
    for (int ps = 0; ps < 4; ++ps) { const int n = ps * 64 + (tid >> 3), kg = tid & 7; float f[8];
#pragma unroll
        for (int j = 0; j < 8; ++j) f[j] = T[(kg * 8 + j) * 257 + n];
        int nd = n0 + n; if (uvperm) { const int mm = nd < DFF ? nd : nd - DFF; nd = (mm >> 7) * 256 + (nd < DFF ? 0 : 128) + (mm & 127); }
        *(u32x4*)(WT + (size_t)nd * K + k0 + kg * 8) = pack8(f); }
}

__device__ __forceinline__ void p0_phase(PP p, unsigned char* shm, int tid_, int bid_, int G_) {
    constexpr int N_ADA = 192, N_CV = 1504;
    for (int it = bid_; it < N_ADA + N_CV; it += G_) {
        if (it < N_ADA) adaln_item(p, it, shm, tid_); else convert_item(p, it - N_ADA, shm, tid_);
    }
}

__device__ __forceinline__ f32x4 ld4_bf16(const bf16_t* p) { const u32x2 w = *(const u32x2*)p; return (f32x4){bf_lo(w.x), bf_hi(w.x), bf_lo(w.y), bf_hi(w.y)}; }
template <bool FINAL>
__device__ __forceinline__ void norm_phase(const float* xpf, const bf16_t* xpb, const float* xsf, const bf16_t* xsb, const float* g, const float* mod, int sh_off, int sc_off, bf16_t* HN, float* Yf, bf16_t* XBw,
                                           const bf16_t* part, int sp, const float* pgate, int tid_, int bid_, int G_) {
    const int lane = tid_ & 63, w = tid_ >> 6;
    const int gw = bid_ * 8 + w, NW = G_ * 8;
    const int wpb = NW >> 3, pb = gw / wpb, pi0 = gw - pb * wpb, npr = (2048 - pi0 + wpb - 1) / wpb, nrow = npr + (gw < MS ? (MS - gw + NW - 1) / NW : 0);
#define ROW(i) ((i) < npr ? pb * 2048 + pi0 + (i) * wpb : MP + gw + ((i) - npr) * NW)
    f32x4 ms[4], mh[4];
#pragma unroll
    for (int j = 0; j < 4; ++j) { ms[j] = *(const f32x4*)(g + 4 * lane + 256 * j); mh[j] = (f32x4){0.f, 0.f, 0.f, 0.f}; }
    int bcur = -1;
    constexpr int NR = 3;
    for (int ib = 0; ib < nrow; ib += NR) {
        f32x4 v[NR][4];
#pragma unroll
        for (int q = 0; q < NR; ++q) { const int R = ROW(ib + q);
            if (ib + q < nrow) {
                const bool smp = R >= MP; const size_t ro = (size_t)(smp ? R - MP : R) * D + 4 * lane;
                const float* xf = smp ? xsf : xpf; const bf16_t* xb = smp ? xsb : xpb;
                if (xf) {
#pragma unroll
                    for (int j = 0; j < 4; ++j) v[q][j] = *(const f32x4*)(xf + ro + 256 * j); }
                else {
#pragma unroll
                    for (int j = 0; j < 4; ++j) v[q][j] = ld4_bf16(xb + ro + 256 * j); } }
            else {
#pragma unroll
                for (int j = 0; j < 4; ++j) v[q][j] = (f32x4){0.f, 0.f, 0.f, 0.f}; } }
#pragma unroll
        for (int q = 0; q < NR; ++q) { const int R = ROW(ib + q);
            if (part && ib + q < nrow && R >= MP) {
                const float* pg = pgate + (size_t)batch_of(R) * NMOD; const bf16_t* pr = part + (size_t)(R - MP) * D;
#pragma unroll
                for (int j = 0; j < 4; ++j) { const int c = 4 * lane + 256 * j; f32x4 a = (f32x4){0.f, 0.f, 0.f, 0.f};
                    for (int ch = 0; ch < sp; ++ch) a += ld4_bf16(pr + (size_t)ch * MS * D + c);
                    v[q][j] += *(const f32x4*)(pg + c) * a; } } }
#pragma unroll
        for (int q = 0; q < NR; ++q) { const int R = ROW(ib + q);
            if (ib + q < nrow) {
                float ss = 0.f;
#pragma unroll
                for (int j = 0; j < 4; ++j) ss += (v[q][j][0] * v[q][j][0] + v[q][j][1] * v[q][j][1]) + (v[q][j][2] * v[q][j][2] + v[q][j][3] * v[q][j][3]);
                ss = wave_sum(ss);
                const float rstd = __builtin_amdgcn_rsqf(ss * (1.0f / D) + 1e-6f);
                if (FINAL) {
#pragma unroll
                    for (int j = 0; j < 4; ++j) *(f32x4*)(Yf + (size_t)R * D + 4 * lane + 256 * j) = v[q][j] * rstd * ms[j];
                } else {
                    const int b = batch_of(R);
                    if (b != bcur) { bcur = b; const float* mb = mod + (size_t)b * NMOD;
#pragma unroll
                        for (int j = 0; j < 4; ++j) { const int c = 4 * lane + 256 * j; ms[j] = *(const f32x4*)(g + c) * (*(const f32x4*)(mb + sc_off + c) + 1.0f); mh[j] = *(const f32x4*)(mb + sh_off + c); } }
                    if (part && R >= MP) {
#pragma unroll
                        for (int j = 0; j < 4; ++j) { u32x2 wv; wv.x = cvt_pk_bf16(v[q][j][0], v[q][j][1]); wv.y = cvt_pk_bf16(v[q][j][2], v[q][j][3]); *(u32x2*)(XBw + (size_t)R * D + 4 * lane + 256 * j) = wv; } }
#pragma unroll
                    for (int j = 0; j < 4; ++j) { const f32x4 o = v[q][j] * rstd * ms[j] + mh[j];
                        u32x2 wv; wv.x = cvt_pk_bf16(o[0], o[1]); wv.y = cvt_pk_bf16(o[2], o[3]);
                        *(u32x2*)(HN + (size_t)R * D + 4 * lane + 256 * j) = wv; }
                }
            } }
    }
#undef ROW
}

constexpr int S1_CONST_BYTES = 11 * 512 * 4;
constexpr int S1_XCB = 0, S1_XCF = 2304, S1_BB = 2304 + 4352, S1_XLS = 11008, S1_ZS = 11008 + 2736, S1_WREG = 16384;
static_assert(S1_CONST_BYTES + 8 * S1_WREG <= LDS_BARW, "scan phase LDS");
__device__ __forceinline__ void s1_phase(PP p, int l, unsigned char* shm, int tid_, int bid_, int G_) {
    const int tid = tid_, lane = tid & 63, h = tid >> 6, fr = lane & 15, fq = lane >> 4;
    float* cst = (float*)shm;
    float* c_cw = cst, *c_cb = cst + 2048, *c_ba = cst + 2560, *c_bx = cst + 3072, *c_sp = cst + 3584, *c_scw = cst + 4096;
    __syncthreads();
    for (int i = tid; i < 2048; i += 512) c_cw[i] = p->in[I_LCW][l * 2048 + i];
    { const int i = tid; c_cb[i] = p->in[I_LCB][l * 512 + i]; c_ba[i] = p->in[I_BA][l * 512 + i]; c_bx[i] = p->in[I_BX][l * 512 + i];
      const float x = -p->in[I_LAM][l * 512 + i]; c_sp[i] = 8.0f * (fmaxf(x, 0.f) + log1pf(__expf(-fabsf(x)))); }
    for (int i = tid; i < 1536; i += 512) c_scw[i] = p->in[I_SCW][l * 1536 + i];
    __syncthreads();
    unsigned char* wreg = shm + S1_CONST_BYTES + h * S1_WREG;
    bf16_t* XCb = (bf16_t*)(wreg + S1_XCB);
    float* XCf = (float*)(wreg + S1_XCF);
    float* BBf = (float*)(wreg + S1_BB);
    bf16x8 wfa[4][2], wfx[4][2];
    {
        const float* Wa = p->in[I_WA] + ((size_t)l * 8 + h) * 4096; const float* Wx = p->in[I_WX] + ((size_t)l * 8 + h) * 4096;
#pragma unroll
        for (int nt = 0; nt < 4; ++nt)
#pragma unroll
            for (int ks = 0; ks < 2; ++ks) { float fa[8], fx[8];
#pragma unroll
                for (int j = 0; j < 8; ++j) { const int k = ks * 32 + fq * 8 + j, n = nt * 16 + fr; fa[j] = Wa[k * 64 + n]; fx[j] = Wx[k * 64 + n]; }
                wfa[nt][ks] = as_bf16x8(pack8(fa)); wfx[nt][ks] = as_bf16x8(pack8(fx)); }
    }
    const bf16_t* PROJ = (const bf16_t*)(p->ws + WS_PROJ);
    bf16_t* MIX = (bf16_t*)(p->ws + WS_HN);
    bf16_t* VB = (bf16_t*)(p->ws + WS_VB);
    float* AGG = (float*)(p->ws + WS_AGG);
    const float* st_h = p->in[I_SH] + (size_t)l * 128 * DH;
    const float* st_lc = p->in[I_SLC] + (size_t)l * 128 * 3 * DH;
    const float* st_sc = p->in[I_SSC] + (size_t)l * 128 * 2 * DH;
    float* out = p->out;
    bf16_t* XLs = (bf16_t*)(wreg + S1_XLS);
    bf16_t* Zs = (bf16_t*)(wreg + S1_ZS);
    const int npt = bid_ < 256 ? (256 - bid_ + G_ - 1) / G_ : 0, nst = bid_ < 64 ? (64 - bid_ + G_ - 1) / G_ : 0;
    const int nit = npt * 4 + nst;
    const int r8 = lane >> 3, cg8 = (lane & 7) * 8, c0 = h * 64 + cg8;
    float hcur = 0.f, Pcur = 1.f;
    u32x4 pxl[2], pcs[2], phs[2], phx, phh; bf16_t pgl[16];
#define S1_R0(it_) ((it_) >= npt * 4 ? MP + (bid_ + ((it_) - npt * 4) * G_) * 16 : (bid_ + ((it_) >> 2) * G_) * 64 + ((it_) & 3) * 16)
#define S1_ISSUE_MAIN(it_) do { const int R0n = S1_R0(it_); const bool smpn = (it_) >= npt * 4; \
        _Pragma("unroll") for (int s_ = 0; s_ < 2; ++s_) { const bf16_t* pr = PROJ + (size_t)(R0n + s_ * 8 + r8) * NIN + c0; \
            pxl[s_] = *(const u32x4*)pr; pcs[s_] = *(const u32x4*)(pr + 1536); phs[s_] = *(const u32x4*)(pr + 2048); } \
        phx = (u32x4){0u, 0u, 0u, 0u}; phh = phx; \
        if (!smpn && (R0n & 2047) != 0) { if (lane < 24) phx = *(const u32x4*)(PROJ + (size_t)(R0n - 3 + r8) * NIN + c0); \
            else if (lane < 40) { const bf16_t* pr = PROJ + (size_t)(R0n - 2 + (r8 - 3)) * NIN + c0; phx = *(const u32x4*)(pr + 1536); phh = *(const u32x4*)(pr + 2048); } } } while (0)
#define S1_ISSUE_GL(it_) do { const int R0n = S1_R0(it_); _Pragma("unroll") for (int row_ = 0; row_ < 16; ++row_) pgl[row_] = PROJ[(size_t)(R0n + row_) * NIN + 512 + h * 64 + lane]; } while (0)
    if (nit > 0) { S1_ISSUE_MAIN(0); S1_ISSUE_GL(0); }
    {
#pragma unroll 1
        for (int it = 0; it < nit; ++it) {
            const bool smp = it >= npt * 4;
            const int ti = bid_ + (it >> 2) * G_, mt = smp ? 0 : (it & 3);
            const int R0 = S1_R0(it);
            if (!smp && mt == 0) { hcur = 0.f; Pcur = 1.f; }
            float xo[2][8], zo[2][8];
#pragma unroll
            for (int s = 0; s < 2; ++s) { const int row = s * 8 + r8; float cv[8], hv[8];
                unpack8(pxl[s], xo[s]); unpack8(pcs[s], cv); unpack8(phs[s], hv);
#pragma unroll
                for (int j = 0; j < 8; ++j) zo[s][j] = cv[j] * hv[j];
                *(u32x4*)(XLs + (3 + row) * 72 + cg8) = pxl[s]; *(u32x4*)(Zs + (2 + row) * 72 + cg8) = pack8(zo[s]); }
            if (lane < 24) *(u32x4*)(XLs + r8 * 72 + cg8) = phx;
            else if (lane < 40) { float cv[8], hv[8], zz[8]; unpack8(phx, cv); unpack8(phh, hv);
#pragma unroll
                for (int j = 0; j < 8; ++j) zz[j] = cv[j] * hv[j];
                *(u32x4*)(Zs + (r8 - 3) * 72 + cg8) = pack8(zz); }
            WAVE_LDS_SYNC();
#pragma unroll
            for (int s = 0; s < 2; ++s) {
                const int row = s * 8 + r8, R = R0 + row;
                int t, T, bsm = 0, bq;
                if (smp) { const int si = R - MP; bsm = si >> 3; t = si & 7; T = 8; bq = bsm; } else { t = R & 2047; T = 2048; bq = R >> 11; }
                float xc[8];
                { const f32x4 b0 = *(const f32x4*)(c_cb + c0), b1 = *(const f32x4*)(c_cb + c0 + 4), w0 = *(const f32x4*)(c_cw + 3 * 512 + c0), w1 = *(const f32x4*)(c_cw + 3 * 512 + c0 + 4);
#pragma unroll
                  for (int j = 0; j < 4; ++j) { xc[j] = b0[j] + w0[j] * xo[s][j]; xc[j + 4] = b1[j] + w1[j] * xo[s][j + 4]; } }
#pragma unroll
                for (int k = 0; k < 3; ++k) {
                    const int tt = t - 3 + k; float xv[8];
                    if (smp && tt < 0) { const float* sp = st_lc + ((size_t)bsm * 3 + (3 + tt)) * DH + c0; const f32x4 a0 = *(const f32x4*)sp, a1 = *(const f32x4*)(sp + 4); xv[0] = a0[0]; xv[1] = a0[1]; xv[2] = a0[2]; xv[3] = a0[3]; xv[4] = a1[0]; xv[5] = a1[1]; xv[6] = a1[2]; xv[7] = a1[3]; }
                    else unpack8(*(const u32x4*)(XLs + (row + k) * 72 + cg8), xv);
                    const f32x4 w0 = *(const f32x4*)(c_cw + k * 512 + c0), w1 = *(const f32x4*)(c_cw + k * 512 + c0 + 4);
                    xc[0] += w0[0] * xv[0]; xc[1] += w0[1] * xv[1]; xc[2] += w0[2] * xv[2]; xc[3] += w0[3] * xv[3]; xc[4] += w1[0] * xv[4]; xc[5] += w1[1] * xv[5]; xc[6] += w1[2] * xv[6]; xc[7] += w1[3] * xv[7];
                }
                *(u32x4*)(XCb + row * 72 + cg8) = pack8(xc);
                *(f32x4*)(XCf + row * 68 + cg8) = (f32x4){xc[0], xc[1], xc[2], xc[3]}; *(f32x4*)(XCf + row * 68 + cg8 + 4) = (f32x4){xc[4], xc[5], xc[6], xc[7]};
                if (t >= T - 3) { float* o = out + (smp ? O_NLC_S : O_NLC_P) + (((size_t)l * (smp ? 128 : 8) + bq) * 3 + (t - (T - 3))) * DH + c0;
                    *(f32x4*)o = (f32x4){xo[s][0], xo[s][1], xo[s][2], xo[s][3]}; *(f32x4*)(o + 4) = (f32x4){xo[s][4], xo[s][5], xo[s][6], xo[s][7]}; }
                float zc[8];
                { const f32x4 w0 = *(const f32x4*)(c_scw + 2 * 512 + c0), w1 = *(const f32x4*)(c_scw + 2 * 512 + c0 + 4);
#pragma unroll
                  for (int j = 0; j < 4; ++j) { zc[j] = w0[j] * zo[s][j]; zc[j + 4] = w1[j] * zo[s][j + 4]; } }
#pragma unroll
                for (int k = 0; k < 2; ++k) {
                    const int tt = t - 2 + k; float zv[8];
                    if (smp && tt < 0) { const float* sp = st_sc + ((size_t)bsm * 2 + (2 + tt)) * DH + c0; const f32x4 a0 = *(const f32x4*)sp, a1 = *(const f32x4*)(sp + 4); zv[0] = a0[0]; zv[1] = a0[1]; zv[2] = a0[2]; zv[3] = a0[3]; zv[4] = a1[0]; zv[5] = a1[1]; zv[6] = a1[2]; zv[7] = a1[3]; }
                    else unpack8(*(const u32x4*)(Zs + (row + k) * 72 + cg8), zv);
                    const f32x4 w0 = *(const f32x4*)(c_scw + k * 512 + c0), w1 = *(const f32x4*)(c_scw + k * 512 + c0 + 4);
                    zc[0] += w0[0] * zv[0]; zc[1] += w0[1] * zv[1]; zc[2] += w0[2] * zv[2]; zc[3] += w0[3] * zv[3]; zc[4] += w1[0] * zv[4]; zc[5] += w1[1] * zv[5]; zc[6] += w1[2] * zv[6]; zc[7] += w1[3] * zv[7];
                }
                { float so[8], bo[8]; unpack8(*(const u32x4*)(PROJ + (size_t)R * NIN + 1024 + c0), bo);
#pragma unroll
                  for (int j = 0; j < 8; ++j) so[j] = bo[j] * zc[j];
                  *(u32x4*)(MIX + (size_t)R * D + 512 + c0) = pack8(so); }
                if (t >= T - 2) { float* o = out + (smp ? O_NSC_S : O_NSC_P) + (((size_t)l * (smp ? 128 : 8) + bq) * 2 + (t - (T - 2))) * DH + c0;
                    *(f32x4*)o = (f32x4){zo[s][0], zo[s][1], zo[s][2], zo[s][3]}; *(f32x4*)(o + 4) = (f32x4){zo[s][4], zo[s][5], zo[s][6], zo[s][7]}; }
            }
            if (it + 1 < nit) S1_ISSUE_MAIN(it + 1);
            WAVE_LDS_SYNC();
            f32x4 ga[4], gx[4];
            {
                const bf16x8 af0 = *(const bf16x8*)(XCb + fr * 72 + fq * 8), af1 = *(const bf16x8*)(XCb + fr * 72 + 32 + fq * 8);
#pragma unroll
                for (int nt = 0; nt < 4; ++nt) {
                    f32x4 a = (f32x4){0.f, 0.f, 0.f, 0.f}, x = (f32x4){0.f, 0.f, 0.f, 0.f};
                    a = __builtin_amdgcn_mfma_f32_16x16x32_bf16(wfa[nt][0], af0, a, 0, 0, 0); a = __builtin_amdgcn_mfma_f32_16x16x32_bf16(wfa[nt][1], af1, a, 0, 0, 0);
                    x = __builtin_amdgcn_mfma_f32_16x16x32_bf16(wfx[nt][0], af0, x, 0, 0, 0); x = __builtin_amdgcn_mfma_f32_16x16x32_bf16(wfx[nt][1], af1, x, 0, 0, 0);
                    ga[nt] = a; gx[nt] = x;
                }
            }
#pragma unroll
            for (int nt = 0; nt < 4; ++nt) {
                const int cl = nt * 16 + 4 * fq, cgl = h * 64 + cl;
                const f32x4 xv = *(const f32x4*)(XCf + fr * 68 + cl), ba = *(const f32x4*)(c_ba + cgl), bx = *(const f32x4*)(c_bx + cgl), sp = *(const f32x4*)(c_sp + cgl);
                f32x4 av, bv;
#pragma unroll
                for (int i = 0; i < 4; ++i) { const float r = sigmoidf_(ga[nt][i] + ba[i]), ig = sigmoidf_(gx[nt][i] + bx[i]);
                    const float la = -sp[i] * r, a = __expf(la), mult = __builtin_amdgcn_sqrtf(fmaxf(1.0f - a * a, 0.f));
                    av[i] = a; bv[i] = mult * ig * xv[i]; }
                *(f32x4*)(XCf + fr * 68 + cl) = av; *(f32x4*)(BBf + fr * 68 + cl) = bv;
            }
            WAVE_LDS_SYNC();
            {
                const int c = h * 64 + lane;
#pragma unroll
                for (int row = 0; row < 16; ++row) {
                    const int R = R0 + row;
                    const float a = XCf[row * 68 + lane], b = BBf[row * 68 + lane], gg = gelu_tanh(bf2f(pgl[row]));
                    if (smp && (row & 7) == 0) hcur = st_h[(size_t)((R - MP) >> 3) * DH + c];
                    hcur = a * hcur + b; Pcur *= a;
                    if (smp) { MIX[(size_t)R * D + c] = f2bf(hcur * gg); if ((row & 7) == 7) out[O_NH_S + ((size_t)l * 128 + ((R - MP) >> 3)) * DH + c] = hcur; }
                    else { MIX[(size_t)R * D + c] = f2bf(hcur * gg); VB[(size_t)R * DH + c] = f2bf(Pcur * gg); }
                }
            }
            if (it + 1 < nit) S1_ISSUE_GL(it + 1);
            WAVE_LDS_SYNC();
            if (!smp && mt == 3) { const int c = h * 64 + lane; AGG[((size_t)ti * 2 + 0) * DH + c] = Pcur; AGG[((size_t)ti * 2 + 1) * DH + c] = hcur; }
        }
    }
#undef S1_R0
#undef S1_ISSUE_MAIN
#undef S1_ISSUE_GL
}

__device__ __forceinline__ void s2_phase(PP p, int l, unsigned char* shm, int tid_, int bid_, int G_) {
    const int tid = tid_;
    float* hin = (float*)shm;
    const float* AGG = (const float*)(p->ws + WS_AGG);
    const bf16_t* VB = (const bf16_t*)(p->ws + WS_VB);
    bf16_t* MIX = (bf16_t*)(p->ws + WS_HN);
    for (int ti = bid_; ti < 256; ti += G_) {
        const int b = ti >> 5, jn = ti & 31, c = tid;
        __syncthreads();
        float hh = 0.f;
        for (int jj = 0; jj < jn; ++jj) { const float P = AGG[((size_t)(b * 32 + jj) * 2 + 0) * DH + c], H = AGG[((size_t)(b * 32 + jj) * 2 + 1) * DH + c]; hh = P * hh + H; }
        hin[c] = hh;
        if (jn == 31) { const float P = AGG[((size_t)ti * 2 + 0) * DH + c], H = AGG[((size_t)ti * 2 + 1) * DH + c]; p->out[O_NH_P + ((size_t)l * 8 + b) * DH + c] = P * hh + H; }
        __syncthreads();
#pragma unroll 2
        for (int i = 0; i < 8; ++i) { const int idx = i * 512 + tid, row = idx >> 6, c0 = (idx & 63) * 8; const size_t R = (size_t)ti * 64 + row;
            float u[8], v[8], o[8]; unpack8(*(const u32x4*)(MIX + R * D + c0), u); unpack8(*(const u32x4*)(VB + R * DH + c0), v);
#pragma unroll
            for (int j = 0; j < 8; ++j) o[j] = u[j] + v[j] * hin[c0 + j];
            *(u32x4*)(MIX + R * D + c0) = pack8(o); }
    }
}

__device__ __forceinline__ void ffn_fixup(PP p, int l, const pg8::StaticOrder& S, int tid_) {
    const float* UH = (const float*)(p->ws + WS_UH); const float* UF = (const float*)(p->ws + WS_UF); bf16_t* ACT = (bf16_t*)(p->ws + WS_ACT);
    const float* fcw = p->in[I_FCW] + (size_t)l * 3 * DFF;
    pg8::Unit u;
    for (int i = 0; S.next(i, u); ++i) {
        const int pm = u.pm; if (pm >= 64 || (pm & 7) == 0) continue;
        float u0[11], vv[11], h1[11], h0[11], uf0[11];
#pragma unroll
        for (int i = 0; i < 11; ++i) { const int e = tid_ + i * 512, rr = e >= DFF ? 1 : 0, f = e - rr * DFF;
            u0[i] = UF[(size_t)(pm * 2 + rr) * NUP + f]; vv[i] = UF[(size_t)(pm * 2 + rr) * NUP + DFF + f];
            h1[i] = UH[(size_t)((pm - 1) * 2 + 1) * DFF + f]; h0[i] = UH[(size_t)((pm - 1) * 2) * DFF + f]; uf0[i] = UF[(size_t)(pm * 2) * NUP + f]; }
#pragma unroll
        for (int i = 0; i < 11; ++i) { const int e = tid_ + i * 512, rr = e >= DFF ? 1 : 0, f = e - rr * DFF;
            const float p1 = rr ? uf0[i] : h1[i], p2 = rr ? h1[i] : h0[i];
            ACT[(size_t)(pm * 256 + rr) * DFF + f] = f2bf(gelu_tanh(fcw[f] * p2 + fcw[DFF + f] * p1 + fcw[2 * DFF + f] * u0[i]) * vv[i]); }
    }
    asm volatile("s_waitcnt vmcnt(0)" ::: "memory");
    __syncthreads();
}

__device__ __forceinline__ void run_phase(PP p, int ph, unsigned char* shm, int rep_idx) {
    int tid_ = threadIdx.x, bid_ = blockIdx.x, G_ = gridDim.x;
    asm volatile("" : "+v"(tid_)); asm volatile("" : "+s"(bid_)); asm volatile("" : "+s"(G_));
    bf16_t* XB = (bf16_t*)(p->ws + WS_XB);
    bf16_t* HN = (bf16_t*)(p->ws + WS_HN);
    const float* MODb = (const float*)(p->ws + WS_MOD);
    bf16_t* WTb = (bf16_t*)(p->ws + WS_WT);
    if (ph == 0) { if (PMASK & 1) p0_phase(p, shm, tid_, bid_, G_); return; }
    const bf16_t* PART = (const bf16_t*)(p->ws + WS_PART);
    if (ph == NPHASE - 1) { if (PMASK & 2) norm_phase<true>(nullptr, XB, nullptr, XB + (size_t)MP * D, p->in[I_FG], nullptr, 0, 0, nullptr, p->out, nullptr, PART, SP_DN, MODb + (size_t)1 * NBATCH * NMOD + 5120, tid_, bid_, G_); return; }
    const int q = ph - 1, l = q / 8, s = q % 8;
    const float* mod = MODb + (size_t)l * NBATCH * NMOD;
    bf16_t* WT = WTb + (size_t)l * LAYER_WT;
    if (s == 0 || s == 5) { if (PMASK & 2) {
        if (s == 0) { if (l == 0) norm_phase<false>(p->in[I_XP], nullptr, p->in[I_XS], nullptr, p->in[I_N1G] + l * D, mod, 0, 1024, HN, nullptr, XB, nullptr, 0, nullptr, tid_, bid_, G_);
                      else norm_phase<false>(nullptr, XB, nullptr, XB + (size_t)MP * D, p->in[I_N1G] + l * D, mod, 0, 1024, HN, nullptr, XB, PART, SP_DN, mod - (size_t)NBATCH * NMOD + 5120, tid_, bid_, G_); }
        else norm_phase<false>(nullptr, XB, l == 0 ? p->in[I_XS] : nullptr, XB + (size_t)MP * D, p->in[I_N2G] + l * D, mod, 3072, 4096, HN, nullptr, XB, PART, SP_OUT, mod + 2048, tid_, bid_, G_); }
    } else if (s == 1) {
        pg8::Gemm g; pg8::EpiBf16 E;
        g.A = HN; g.Bt = WT + WT_IN; g.M = MT; g.N = NIN; g.K = D; g.lda = D; g.ldb = D; E.O = (bf16_t*)(p->ws + WS_PROJ); E.ldc = NIN;
        pg8::StaticOrder S; S.init(g.M, g.N, g.K, G_, bid_, 0);
        if (PMASK & 4) pg8::gemm_phase<pg8::EpiBf16>((LAS unsigned char*)shm, g, S, E, tid_);
    } else if (s == 6) {
        pg8::Gemm g; pg8::EpiFfn E;
        g.A = HN; g.Bt = WT + WT_UP; g.M = MT; g.N = NUP; g.K = D; g.lda = D; g.ldb = D;
        E.ACT = (bf16_t*)(p->ws + WS_ACT); E.UH = (float*)(p->ws + WS_UH); E.UF = (float*)(p->ws + WS_UF); E.fcw = p->in[I_FCW] + (size_t)l * 3 * DFF; E.st_fc = p->in[I_SFC] + (size_t)l * 128 * 2 * DFF;
        E.nfc_p = p->out + O_NFC_P + (size_t)l * 8 * 2 * DFF; E.nfc_s = p->out + O_NFC_S + (size_t)l * 128 * 2 * DFF; E.xch = (LAS float*)((LAS unsigned char*)shm + LDS_XCH);
        pg8::StaticOrder S; S.init(g.M, g.N, g.K, G_, bid_, 0);
        if (PMASK & 64) pg8::gemm_phase<pg8::EpiFfn>((LAS unsigned char*)shm, g, S, E, tid_);
    } else if (s == 4 || s == 7) {
        pg8::Gemm g; pg8::EpiRes E;
        if (s == 4) { g.A = HN; g.Bt = WT + WT_OUT; g.M = MT; g.N = D; g.K = D; g.lda = D; g.ldb = D; E.Xf = l == 0 ? p->in[I_XP] : nullptr; E.Xin = XB; E.X = XB; E.gate = mod + 2048; }
        else { g.A = (const bf16_t*)(p->ws + WS_ACT); g.Bt = WT + WT_DN; g.M = MT; g.N = D; g.K = DFF; g.lda = DFF; g.ldb = DFF; E.Xf = nullptr; E.Xin = XB; E.X = XB; E.gate = mod + 5120; }
        pg8::StaticOrder S; S.init(g.M, g.N, g.K, G_, bid_, s == 4 ? SP_OUT : SP_DN); E.nkt = S.nkt; E.part = (bf16_t*)(p->ws + WS_PART); E.scale = rep_idx > 0 ? 0.f : 1.f;
        if (s == 7) ffn_fixup(p, l, S, tid_);
        if (PMASK & 8) pg8::gemm_phase<pg8::EpiRes>((LAS unsigned char*)shm, g, S, E, tid_);
    } else if (s == 2) { if (PMASK & 16) s1_phase(p, l, shm, tid_, bid_, G_);
    } else { if (PMASK & 32) s2_phase(p, l, shm, tid_, bid_, G_); }
}

__global__ __launch_bounds__(512, 2) void mega(Params p_unused) {
    extern __shared__ __attribute__((aligned(16))) unsigned char shm[];
    cg::grid_group grid = cg::this_grid();
    PP pp = (PP)__builtin_amdgcn_kernarg_segment_ptr();
    const int ph_lo = pp->ph_lo, ph_hi = pp->ph_hi;
    const int rep_ph = pp->rep_ph, rep_n = pp->rep_n;
    if (ph_lo < 0) grid.sync();
    volatile LAS unsigned* st = (volatile LAS unsigned*)((LAS unsigned char*)shm + LDS_BARW);
    if (threadIdx.x == 0) { st[0] = 0u; st[1] = 0u; }
    __syncthreads();
    XcdBarrier xb = xcd_barrier_post((unsigned*)(pp->ws + WS_BAR), st);
    if (rep_ph == 1000) for (int r = 0; r < rep_n; ++r) xcd_barrier(xb);
    for (int ph = ph_lo; ph < ph_hi; ++ph) {
        const int reps = (ph == rep_ph) ? rep_n + 1 : 1;
        for (int r = 0; r < reps; ++r) {
            asm volatile("" : "+s"(pp));
            run_phase(pp, ph, shm, r);
            if (r + 1 < reps) xcd_barrier(xb);
        }
        if (ph + 1 < ph_hi) xcd_barrier(xb);
    }
}

extern "C" void kernel_launch(void* const* d_in, const int* in_sizes, int n_in, void* d_out, int out_size, void* d_ws, size_t ws_size, hipStream_t stream) {
    static int grid = 0;
    if (grid == 0) {
        if (n_in != 26 || (size_t)out_size != O_END || ws_size < WS_BAR + XCD_BAR_WORDS * 4) { fprintf(stderr, "kernel_launch: unexpected sizes n_in %d out %d ws %zu (need %zu)\n", n_in, out_size, ws_size, (size_t)WS_END); grid = -1; return; }
        int dev = 0, cus = 0, per_cu = 0;
        hipGetDevice(&dev); hipDeviceGetAttribute(&cus, hipDeviceAttributeMultiprocessorCount, dev);
        if (hipFuncSetAttribute((const void*)mega, hipFuncAttributeMaxDynamicSharedMemorySize, LDS_BYTES) != hipSuccess) { fprintf(stderr, "kernel_launch: hipFuncSetAttribute failed\n"); grid = -1; return; }
        if (hipOccupancyMaxActiveBlocksPerMultiprocessor(&per_cu, (const void*)mega, 512, LDS_BYTES) != hipSuccess || per_cu < 1) { fprintf(stderr, "kernel_launch: occupancy query failed (%d)\n", per_cu); (void)hipGetLastError(); per_cu = 1; }
        grid = cus * 1;
        if (per_cu < 1) grid = -1;
    }
    if (grid < 0) return;
    if (hipMemsetAsync((char*)d_ws + WS_BAR, 0, XCD_BAR_WORDS * 4, stream) != hipSuccess) { fprintf(stderr, "kernel_launch: memset of the barrier words failed\n"); return; }
    Params p{};
    for (int i = 0; i < 26; ++i) p.in[i] = (const float*)d_in[i];
    p.out = (float*)d_out; p.ws = (unsigned char*)d_ws; p.rep_ph = REP_PH; p.rep_n = REP_N;
#if N_LAUNCH_SPLIT
    for (int ph = 0; ph < NPHASE; ++ph) {
        p.ph_lo = ph; p.ph_hi = ph + 1;
        void* args[] = {&p};
        hipError_t e = hipLaunchCooperativeKernel((const void*)mega, dim3(grid), dim3(512), args, LDS_BYTES, stream);
        if (e != hipSuccess) { fprintf(stderr, "cooperative launch failed: %s (grid %d)\n", hipGetErrorString(e), grid); break; }
    }
#else
    p.ph_lo = 0; p.ph_hi = NPHASE;
    void* args[] = {&p};
    hipError_t e = hipLaunchCooperativeKernel((const void*)mega, dim3(grid), dim3(512), args, LDS_BYTES, stream);
    if (e != hipSuccess) fprintf(stderr, "cooperative launch failed: %s (grid %d)\n", hipGetErrorString(e), grid);
#endif
}
```

```cpp
#include <hip/hip_runtime.h>
#include <hip/hip_cooperative_groups.h>
#include <cstdio>
#include <cstdint>
namespace cg = cooperative_groups;

#define LAS __attribute__((address_space(3)))
typedef unsigned short bf16_t;
typedef short bf16x8 __attribute__((ext_vector_type(8)));
typedef float f32x4 __attribute__((ext_vector_type(4)));
typedef unsigned u32x4 __attribute__((ext_vector_type(4)));
typedef unsigned u32x2 __attribute__((ext_vector_type(2)));

constexpr int D = 1024, DH = 512, NIN = 2560, DFF = 2816, NUP = 5632;
constexpr int MP = 16384, MS = 1024, MT = 17408, NBATCH = 136, NMOD = 6144;
#ifndef N_LAUNCH_SPLIT
#define N_LAUNCH_SPLIT 0
#endif
constexpr int NPHASE = 18;
constexpr int SP_OUT = 8, SP_DN = 11;
static_assert((D / 64) % SP_OUT == 0 && ((D / 64) / SP_OUT) % 2 == 0 && (DFF / 64) % SP_DN == 0 && ((DFF / 64) / SP_DN) % 2 == 0 && SP_OUT <= 11 && SP_DN <= 11, "split chunk sizes");
#define REP_PH -1
#define REP_N 0
#ifndef PMASK
#define PMASK 127
#endif

enum { I_XP = 0, I_XS, I_CP, I_CS, I_SH, I_SLC, I_SSC, I_SFC, I_WADA, I_BADA, I_N1G, I_N2G, I_WIN, I_LCW, I_LCB, I_WA, I_BA, I_WX, I_BX, I_LAM, I_SCW, I_WOUT, I_WUP, I_FCW, I_WDN, I_FG };
constexpr size_t O_Y = 0, O_NH_P = 17825792, O_NLC_P = 17833984, O_NSC_P = 17858560, O_NFC_P = 17874944, O_NH_S = 17965056, O_NLC_S = 18096128, O_NSC_S = 18489344, O_NFC_S = 18751488, O_END = 20193280;
constexpr size_t LAYER_WT = 12320768, WT_IN = 0, WT_OUT = 2621440, WT_UP = 3670016, WT_DN = 9437184;
constexpr size_t WS_WT = 0, WS_MOD = 49283072, WS_AGG = WS_MOD + 6684672, WS_HN = WS_AGG + 1114112, WS_R1 = WS_HN + 35651584;
constexpr size_t WS_PROJ = WS_R1, WS_VB = WS_R1 + 89128960;
constexpr size_t WS_ACT = WS_R1;
constexpr size_t WS_UH = WS_R1 + 106954752, WS_UF = WS_UH + 1531904, WS_PART = WS_UF + 3063808, WS_XB = WS_PART + 23068672, WS_END = WS_XB + 35651584;
constexpr int LDS_XCH = 131072, LDS_BARW = 153600, LDS_BYTES = 153600 + 64;
constexpr size_t WS_BAR = WS_END;

struct Params { const float* in[26]; float* out; unsigned char* ws; int ph_lo, ph_hi, rep_ph, rep_n; };
#define CAS __attribute__((address_space(4)))
typedef const CAS Params* PP;

__device__ __forceinline__ unsigned cvt_pk_bf16(float lo, float hi) { unsigned r; asm volatile("v_cvt_pk_bf16_f32 %0, %1, %2" : "=v"(r) : "v"(lo), "v"(hi)); return r; }
__device__ __forceinline__ bf16_t f2bf(float f) { return (bf16_t)(cvt_pk_bf16(f, 0.f) & 0xffffu); }
__device__ __forceinline__ float bf_lo(unsigned w) { return __uint_as_float(w << 16); }
__device__ __forceinline__ float bf_hi(unsigned w) { return __uint_as_float(w & 0xffff0000u); }
__device__ __forceinline__ float bf2f(bf16_t b) { return __uint_as_float(((unsigned)b) << 16); }
__device__ __forceinline__ void unpack8(u32x4 w, float (&f)[8]) { f[0] = bf_lo(w.x); f[1] = bf_hi(w.x); f[2] = bf_lo(w.y); f[3] = bf_hi(w.y); f[4] = bf_lo(w.z); f[5] = bf_hi(w.z); f[6] = bf_lo(w.w); f[7] = bf_hi(w.w); }
__device__ __forceinline__ u32x4 pack8(const float (&f)[8]) { u32x4 w; w.x = cvt_pk_bf16(f[0], f[1]); w.y = cvt_pk_bf16(f[2], f[3]); w.z = cvt_pk_bf16(f[4], f[5]); w.w = cvt_pk_bf16(f[6], f[7]); return w; }
__device__ __forceinline__ bf16x8 as_bf16x8(u32x4 w) { return __builtin_bit_cast(bf16x8, w); }
__device__ __forceinline__ float sigmoidf_(float x) { return __builtin_amdgcn_rcpf(1.0f + __expf(-x)); }
__device__ __forceinline__ float gelu_tanh(float x) { const float a = x * __builtin_fmaf(x * x, -0.10294323957f, -2.3022081979f); return x * __builtin_amdgcn_rcpf(1.0f + __builtin_amdgcn_exp2f(a)); }
__device__ __forceinline__ float wave_sum(float v) {
#pragma unroll
    for (int o = 1; o < 64; o <<= 1) v += __shfl_xor(v, o);
    return v;
}
__device__ __forceinline__ int batch_of(int R) { return R < MP ? (R >> 11) : 8 + ((R - MP) >> 3); }
#define WAVE_LDS_SYNC() asm volatile("s_waitcnt lgkmcnt(0)" ::: "memory")


#define XB_TMO      128
#define XB_XCNT(j)  (256  + 64 * (j))
#define XB_XSUB(j)  (1280 + 64 * (j))
#define XB_XGEN(j)  (2304 + 64 * (j))
#define XB_TOP      3328
#define XB_TOPGEN   3392
#define XCD_BAR_WORDS 3456
#define XB_SPIN_CAP (1u << 20)
__device__ __forceinline__ unsigned xb_ld(unsigned* p)              { return __hip_atomic_load(p, __ATOMIC_RELAXED, __HIP_MEMORY_SCOPE_AGENT); }
__device__ __forceinline__ unsigned xb_add(unsigned* p, unsigned v) { return __hip_atomic_fetch_add(p, v, __ATOMIC_RELAXED, __HIP_MEMORY_SCOPE_AGENT); }
__device__ __forceinline__ unsigned xb_xcc_id() { return (unsigned)__builtin_amdgcn_s_getreg((3 << 11) | 20) & 0xFu; }
#define XB_SPIN(cond, bar) do { unsigned _sp = 0; while (cond) { __builtin_amdgcn_s_sleep(1); \
    if ((++_sp & 255u) == 0u) { if (xb_ld(&(bar)[XB_TMO])) break; if (_sp > XB_SPIN_CAP) { atomicAdd(&(bar)[XB_TMO], 1u); break; } } } } while (0)
struct XcdBarrier { unsigned* bar; unsigned x; volatile LAS unsigned* st; };
__device__ __forceinline__ XcdBarrier xcd_barrier_post(unsigned* bar, volatile LAS unsigned* st) {
    XcdBarrier b; b.bar = bar; b.x = xb_xcc_id(); b.st = st;
    if (threadIdx.x == 0) (void)xb_add(&bar[XB_XCNT(b.x)], 1u);
    return b;
}
__device__ __forceinline__ void xcd_barrier_complete(unsigned* bar, unsigned x, unsigned& nloc, unsigned& nx) {
    const unsigned G = gridDim.x * gridDim.y * gridDim.z;
    unsigned sum, cnt, mine, sp = 0u;
    for (;;) {
        sum = 0u; cnt = 0u; mine = 0u;
#pragma unroll
        for (unsigned j = 0; j < 16; ++j) { const unsigned c = xb_ld(&bar[XB_XCNT(j)]); sum += c; cnt += (c > 0u) ? 1u : 0u; mine = (j == x) ? c : mine; }
        if (sum == G) break;
        __builtin_amdgcn_s_sleep(1);
        if ((++sp & 255u) == 0u) { if (xb_ld(&bar[XB_TMO])) break; if (sp > XB_SPIN_CAP) { atomicAdd(&bar[XB_TMO], 1u); break; } }
    }
    nloc = mine > 0u ? mine : 1u; nx = cnt > 0u ? cnt : 1u;
}
__device__ __forceinline__ void xcd_barrier(const XcdBarrier& b) {
    asm volatile("s_waitcnt vmcnt(0)" ::: "memory");
    __syncthreads();
    if (threadIdx.x == 0) {
        unsigned* bar = b.bar;
        __builtin_amdgcn_s_waitcnt(0);
        unsigned nloc = b.st[0], nx = b.st[1];
        if (nloc == 0u) { xcd_barrier_complete(bar, b.x, nloc, nx); b.st[0] = nloc; b.st[1] = nx; }
        const unsigned old = xb_add(&bar[XB_XSUB(b.x)], 1u);
        const unsigned gen = old / nloc;
        if (old + 1u == (gen + 1u) * nloc) {
            __builtin_amdgcn_fence(__ATOMIC_RELEASE, "agent");
            asm volatile("s_waitcnt vmcnt(0)" ::: "memory");
            const unsigned og = xb_add(&bar[XB_TOP], 1u);
            const unsigned tg = og / nx;
            if (og + 1u == (tg + 1u) * nx) xb_add(&bar[XB_TOPGEN], 1u);
            else XB_SPIN(xb_ld(&bar[XB_TOPGEN]) == tg, bar);
            __builtin_amdgcn_fence(__ATOMIC_ACQUIRE, "agent");
            xb_add(&bar[XB_XGEN(b.x)], 1u);
            asm volatile("s_waitcnt vmcnt(0)" ::: "memory");
        } else {
            XB_SPIN(xb_ld(&bar[XB_XGEN(b.x)]) == gen, bar);
            __builtin_amdgcn_fence(__ATOMIC_ACQUIRE, "agent");
            asm volatile("s_waitcnt vmcnt(0)" ::: "memory");
        }
    }
    __syncthreads();
}

namespace pg8 {
constexpr int BM = 256, BK = 64, HALF = 128, HTB = HALF * BK * 2, STAGE_BYTES = 8 * HTB, NXCD = 8, WGM = 8;
__host__ __device__ __forceinline__ int lds_byte(int r, int c) { const int st = (r >> 4) * 2 + (c >> 5), rr = r & 15, cc = c & 31, ob = rr * 64 + cc * 2; return st * 1024 + (ob ^ (((ob >> 9) & 1) << 5)); }
__host__ __device__ __forceinline__ void stage_rc(int b, int& R, int& C) { const int st = b / 1024, sb = b % 1024, swz = sb ^ (((sb >> 9) & 1) << 5); R = (st >> 1) * 16 + swz / 64; C = (st & 1) * 32 + (swz % 64) / 2; }
__host__ __device__ __forceinline__ int perm32(int rho) { const int n = rho >> 4, i = rho & 15; return 8 * (i >> 2) + 4 * n + (i & 3); }
struct Unit { int pm, pn, kt0, nk; };
struct Gemm { const bf16_t* A; const bf16_t* Bt; int M, N, K, lda, ldb; };
struct StaticOrder {
    int nM, nN, nwg, G, c, nMf, nfull, nsm, sp, nkt, nks;
    __device__ void init(int M, int N, int K, int G_, int c_, int split_sp) {
        nM = M / BM; nN = N / BM; nwg = nM * nN; G = G_; c = c_; nkt = K / BK; nMf = nM; nfull = nwg; nsm = 0; sp = 1; nks = nkt;
        if (split_sp > 1) { sp = split_sp; nks = nkt / sp; nMf = MP / BM; nfull = nMf * nN; nsm = (nM - nMf) * nN; }
    }
    __device__ void tile(int L, Unit& u) const {
        int wgid = L; { const int q = nfull / NXCD, r = nfull % NXCD, xcd = wgid % NXCD, off = wgid / NXCD; wgid = (xcd < r ? xcd * (q + 1) : r * (q + 1) + (xcd - r) * q) + off; }
        const int nig = WGM * nN, gid = wgid / nig, fm = gid * WGM, gsz = (nMf - fm) < WGM ? (nMf - fm) : WGM;
        u.pm = fm + ((wgid % nig) % gsz); u.pn = (wgid % nig) / gsz;
    }
    __device__ bool next(int i, Unit& u) const {
        const long L = (long)i * G + c;
        if (L < nfull) { tile((int)L, u); u.kt0 = 0; u.nk = nkt; return true; }
        const long j = L - nfull;
        if (j >= (long)nsm * sp) return false;
        const int jt = (int)(j / sp); u.pm = nMf + jt / nN; u.pn = jt % nN; u.kt0 = (int)(j % sp) * nks; u.nk = nks; return true;
    }
};

struct EpiBf16 {
    static constexpr bool PERM = true;
    bf16_t* O; int ldc;
    __device__ __forceinline__ void operator()(const f32x4 (&acc)[2][2][4][2], const Unit& u, int wr, int wc, int fr, int fq) const {
        const int row0 = u.pm * BM + wr * 64 + fr, col0 = u.pn * BM + wc * 32 + 8 * fq;
#pragma unroll
        for (int ai = 0; ai < 2; ++ai)
#pragma unroll
            for (int m = 0; m < 4; ++m) { bf16_t* rowp = O + (size_t)(row0 + ai * HALF + m * 16) * ldc + col0;
#pragma unroll
                for (int bj = 0; bj < 2; ++bj) { const f32x4 v0 = acc[ai][bj][m][0], v1 = acc[ai][bj][m][1];
                    u32x4 w; w.x = cvt_pk_bf16(v0[0], v0[1]); w.y = cvt_pk_bf16(v0[2], v0[3]); w.z = cvt_pk_bf16(v1[0], v1[1]); w.w = cvt_pk_bf16(v1[2], v1[3]);
                    *(u32x4*)(rowp + bj * HALF) = w; } }
    }
};
struct EpiRes {
    static constexpr bool PERM = true;
    const float* Xf; const bf16_t* Xin; bf16_t* X; const float* gate; bf16_t* part; int nkt; float scale;
    __device__ __forceinline__ void operator()(const f32x4 (&acc)[2][2][4][2], const Unit& u, int wr, int wc, int fr, int fq) const {
        const int Rt = u.pm * BM, c0 = u.pn * BM + wc * 32 + 8 * fq;
        if (u.nk != nkt) {
            bf16_t* pb = part + ((size_t)(u.kt0 / u.nk) * MS + (Rt - MP) + wr * 64 + fr) * D + c0;
#pragma unroll
            for (int ai = 0; ai < 2; ++ai)
#pragma unroll
                for (int m = 0; m < 4; ++m)
#pragma unroll
                    for (int bj = 0; bj < 2; ++bj) { const f32x4 v0 = acc[ai][bj][m][0], v1 = acc[ai][bj][m][1];
                        u32x4 w; w.x = cvt_pk_bf16(v0[0], v0[1]); w.y = cvt_pk_bf16(v0[2], v0[3]); w.z = cvt_pk_bf16(v1[0], v1[1]); w.w = cvt_pk_bf16(v1[2], v1[3]);
                        *(u32x4*)(pb + (size_t)(ai * HALF + m * 16) * D + bj * HALF) = w; }
        } else {
            const float* gp = gate + (size_t)(Rt >> 11) * NMOD + c0;
            f32x4 gv[2][2];
#pragma unroll
            for (int bj = 0; bj < 2; ++bj)
#pragma unroll
                for (int n = 0; n < 2; ++n) gv[bj][n] = *(const f32x4*)(gp + bj * HALF + n * 4) * scale;
            const size_t ro = (size_t)(Rt + wr * 64 + fr) * D + c0;
            bf16_t* xr = X + ro;
            if (Xf) {
                const float* xi = Xf + ro;
                f32x4 xa[2][2], xb[2][2];
#pragma unroll
                for (int bj = 0; bj < 2; ++bj)
#pragma unroll
                    for (int n = 0; n < 2; ++n) xa[bj][n] = *(const f32x4*)(xi + bj * HALF + n * 4);
#pragma unroll
                for (int grp = 0; grp < 8; ++grp) {
                    const int ai = grp >> 2, m = grp & 3;
                    if (grp + 1 < 8) { const float* xn = xi + (size_t)(((grp + 1) >> 2) * HALF + ((grp + 1) & 3) * 16) * D;
#pragma unroll
                        for (int bj = 0; bj < 2; ++bj)
#pragma unroll
                            for (int n = 0; n < 2; ++n) { if (grp & 1) xa[bj][n] = *(const f32x4*)(xn + bj * HALF + n * 4); else xb[bj][n] = *(const f32x4*)(xn + bj * HALF + n * 4); } }
                    bf16_t* xo = xr + (size_t)(ai * HALF + m * 16) * D;
#pragma unroll
                    for (int bj = 0; bj < 2; ++bj) { const f32x4 v0 = ((grp & 1) ? xb[bj][0] : xa[bj][0]) + gv[bj][0] * acc[ai][bj][m][0], v1 = ((grp & 1) ? xb[bj][1] : xa[bj][1]) + gv[bj][1] * acc[ai][bj][m][1];
                        u32x4 w; w.x = cvt_pk_bf16(v0[0], v0[1]); w.y = cvt_pk_bf16(v0[2], v0[3]); w.z = cvt_pk_bf16(v1[0], v1[1]); w.w = cvt_pk_bf16(v1[2], v1[3]);
                        *(u32x4*)(xo + bj * HALF) = w; }
                }
            } else {
                const bf16_t* xi = Xin + ro;
                u32x4 xa[2], xb[2];
#pragma unroll
                for (int bj = 0; bj < 2; ++bj) xa[bj] = *(const u32x4*)(xi + bj * HALF);
#pragma unroll
                for (int grp = 0; grp < 8; ++grp) {
                    const int ai = grp >> 2, m = grp & 3;
                    if (grp + 1 < 8) { const bf16_t* xn = xi + (size_t)(((grp + 1) >> 2) * HALF + ((grp + 1) & 3) * 16) * D;
#pragma unroll
                        for (int bj = 0; bj < 2; ++bj) { if (grp & 1) xa[bj] = *(const u32x4*)(xn + bj * HALF); else xb[bj] = *(const u32x4*)(xn + bj * HALF); } }
                    bf16_t* xo = xr + (size_t)(ai * HALF + m * 16) * D;
#pragma unroll
                    for (int bj = 0; bj < 2; ++bj) { const u32x4 xw = (grp & 1) ? xb[bj] : xa[bj];
                        const f32x4 x0 = (f32x4){bf_lo(xw.x), bf_hi(xw.x), bf_lo(xw.y), bf_hi(xw.y)}, x1 = (f32x4){bf_lo(xw.z), bf_hi(xw.z), bf_lo(xw.w), bf_hi(xw.w)};
                        const f32x4 v0 = x0 + gv[bj][0] * acc[ai][bj][m][0], v1 = x1 + gv[bj][1] * acc[ai][bj][m][1];
                        u32x4 w; w.x = cvt_pk_bf16(v0[0], v0[1]); w.y = cvt_pk_bf16(v0[2], v0[3]); w.z = cvt_pk_bf16(v1[0], v1[1]); w.w = cvt_pk_bf16(v1[2], v1[3]);
                        *(u32x4*)(xo + bj * HALF) = w; }
                }
            }
        }
    }
};

__device__ __forceinline__ float dpp_ror1(float v) { return __int_as_float(__builtin_amdgcn_mov_dpp(__float_as_int(v), 0x121, 0xf, 0xf, true)); }
__device__ __forceinline__ float dpp_ror2(float v) { return __int_as_float(__builtin_amdgcn_mov_dpp(__float_as_int(v), 0x122, 0xf, 0xf, true)); }
__device__ __forceinline__ float dpp_shr1_old(float old, float v) { return __int_as_float(__builtin_amdgcn_update_dpp(__float_as_int(old), __float_as_int(v), 0x111, 0xf, 0xf, false)); }
__device__ __forceinline__ float dpp_shr2_old(float old, float v) { return __int_as_float(__builtin_amdgcn_update_dpp(__float_as_int(old), __float_as_int(v), 0x112, 0xf, 0xf, false)); }
struct EpiFfn {
    static constexpr bool PERM = true;
    bf16_t* ACT; float* UH; float* UF; const float* fcw; const float* st_fc; float* nfc_p; float* nfc_s; LAS float* xch;
    __device__ __forceinline__ void operator()(const f32x4 (&acc)[2][2][4][2], const Unit& u, int wr, int wc, int fr, int fq) const {
        const int f0 = u.pn * 128 + wc * 32 + 8 * fq, Rt = u.pm * BM;
        float w0[8], w1[8], w2[8];
        { const f32x4 a0 = *(const f32x4*)(fcw + f0), a1 = *(const f32x4*)(fcw + f0 + 4), b0 = *(const f32x4*)(fcw + DFF + f0), b1 = *(const f32x4*)(fcw + DFF + f0 + 4), c0 = *(const f32x4*)(fcw + 2 * DFF + f0), c1 = *(const f32x4*)(fcw + 2 * DFF + f0 + 4);
#pragma unroll
          for (int j = 0; j < 4; ++j) { w0[j] = a0[j]; w0[j + 4] = a1[j]; w1[j] = b0[j]; w1[j + 4] = b1[j]; w2[j] = c0[j]; w2[j + 4] = c1[j]; } }
        __builtin_amdgcn_s_waitcnt(0x0F70);
        const unsigned xch_b = (unsigned)(uintptr_t)xch;
        if (Rt < MP) {
            if (fr >= 14) {
#pragma unroll
                for (int ai = 0; ai < 2; ++ai) { const unsigned d = xch_b + (unsigned)(((((ai * 2 + wr) * 4 + wc) * 2 + (fr - 14)) * 4 + fq) * 32);
                    asm volatile("ds_write_b128 %0, %1" :: "v"(d), "v"(acc[ai][0][3][0]) : "memory"); asm volatile("ds_write_b128 %0, %1 offset:16" :: "v"(d), "v"(acc[ai][0][3][1]) : "memory"); } }
            asm volatile("s_waitcnt lgkmcnt(0)" ::: "memory"); __builtin_amdgcn_s_barrier(); asm volatile("" ::: "memory");
#pragma unroll
            for (int ai = 0; ai < 2; ++ai) {
                float e14[8], e15[8];
                if (ai == 0 && wr == 0) {
#pragma unroll
                    for (int j = 0; j < 8; ++j) { e14[j] = 0.f; e15[j] = 0.f; }
                } else { const int pa = wr ? ai : 0, pw = wr ? 0 : 1; const unsigned sp = xch_b + (unsigned)(((((pa * 2 + pw) * 4 + wc) * 2 + 0) * 4 + fq) * 32);
                    f32x4 a0, a1, b0, b1;
                    asm volatile("ds_read_b128 %0, %1" : "=v"(a0) : "v"(sp) : "memory"); asm volatile("ds_read_b128 %0, %1 offset:16" : "=v"(a1) : "v"(sp) : "memory");
                    asm volatile("ds_read_b128 %0, %1 offset:128" : "=v"(b0) : "v"(sp) : "memory"); asm volatile("ds_read_b128 %0, %1 offset:144" : "=v"(b1) : "v"(sp) : "memory");
                    asm volatile("s_waitcnt lgkmcnt(0)" : "+v"(a0), "+v"(a1), "+v"(b0), "+v"(b1) :: "memory");
#pragma unroll
                    for (int j = 0; j < 4; ++j) { e14[j] = a0[j]; e14[j + 4] = a1[j]; e15[j] = b0[j]; e15[j + 4] = b1[j]; } }
#pragma unroll
                for (int m = 0; m < 4; ++m) {
                    float o[8];
#pragma unroll
                    for (int j = 0; j < 8; ++j) {
                        const float U = acc[ai][0][m][j >> 2][j & 3], V = acc[ai][1][m][j >> 2][j & 3];
                        float o1, o2;
                        if (m > 0) { const float Up = acc[ai][0][m > 0 ? m - 1 : 0][j >> 2][j & 3]; o1 = dpp_ror1(Up); o2 = dpp_ror2(Up); }
                        else { o1 = e15[j]; o2 = (fr == 0) ? e14[j] : e15[j]; }
                        const float p1 = dpp_shr1_old(o1, U), p2 = dpp_shr2_old(o2, U);
                        o[j] = gelu_tanh(w0[j] * p2 + w1[j] * p1 + w2[j] * U) * V;
                    }
                    *(u32x4*)(ACT + (size_t)(Rt + ai * HALF + wr * 64 + m * 16 + fr) * DFF + f0) = pack8(o);
                }
            }
            if (wr == 1 && fr >= 14) { float* d = UH + (size_t)(u.pm * 2 + (fr - 14)) * DFF + f0; *(f32x4*)d = acc[1][0][3][0]; *(f32x4*)(d + 4) = acc[1][0][3][1];
                if ((u.pm & 7) == 7) { float* q = nfc_p + (size_t)((u.pm >> 3) * 2 + (fr - 14)) * DFF + f0; *(f32x4*)q = acc[1][0][3][0]; *(f32x4*)(q + 4) = acc[1][0][3][1]; } }
            if (wr == 0 && fr < 2) { float* d = UF + (size_t)(u.pm * 2 + fr) * NUP + f0; *(f32x4*)d = acc[0][0][0][0]; *(f32x4*)(d + 4) = acc[0][0][0][1]; *(f32x4*)(d + DFF) = acc[0][1][0][0]; *(f32x4*)(d + DFF + 4) = acc[0][1][0][1]; }
        } else {
            const int t = fr & 7;
#pragma unroll
            for (int ai = 0; ai < 2; ++ai)
#pragma unroll
                for (int m = 0; m < 4; ++m) {
                    const int R = Rt + ai * HALF + wr * 64 + m * 16 + fr, b = (R - MP) >> 3;
                    float s0[8], s1[8];
#pragma unroll
                    for (int j = 0; j < 8; ++j) { s0[j] = 0.f; s1[j] = 0.f; }
                    if (t < 2) { const float* sp = st_fc + (size_t)b * 2 * DFF + f0; const f32x4 b0 = *(const f32x4*)(sp + DFF), b1 = *(const f32x4*)(sp + DFF + 4);
#pragma unroll
                        for (int j = 0; j < 4; ++j) { s1[j] = b0[j]; s1[j + 4] = b1[j]; }
                        if (t == 0) { const f32x4 a0 = *(const f32x4*)sp, a1 = *(const f32x4*)(sp + 4);
#pragma unroll
                            for (int j = 0; j < 4; ++j) { s0[j] = a0[j]; s0[j + 4] = a1[j]; } } }
                    float o[8];
#pragma unroll
                    for (int j = 0; j < 8; ++j) {
                        const float U = acc[ai][0][m][j >> 2][j & 3], V = acc[ai][1][m][j >> 2][j & 3];
                        const float r1 = dpp_ror1(U), r2 = dpp_ror2(U);
                        const float p1 = (t == 0) ? s1[j] : r1, p2 = (t == 0) ? s0[j] : ((t == 1) ? s1[j] : r2);
                        o[j] = gelu_tanh(w0[j] * p2 + w1[j] * p1 + w2[j] * U) * V;
                    }
                    *(u32x4*)(ACT + (size_t)R * DFF + f0) = pack8(o);
                    if (t >= 6) { float* q = nfc_s + (size_t)(b * 2 + (t - 6)) * DFF + f0; *(f32x4*)q = acc[ai][0][m][0]; *(f32x4*)(q + 4) = acc[ai][0][m][1]; }
                }
        }
    }
};

template <class Epi>
__device__ __forceinline__ void gemm_phase(LAS unsigned char* lds, const Gemm g, const StaticOrder& S, const Epi& E, int tid_) {
    const int tid = tid_, wid = __builtin_amdgcn_readfirstlane(tid >> 6), lane = tid & 63, wr = wid >> 2, wc = wid & 3, fr = lane & 15, fq = lane >> 4;
    unsigned voffA[2], voffB[2];
#pragma unroll
    for (int i = 0; i < 2; ++i) { int R, C; stage_rc(tid * 16 + i * 8192, R, C); const int Rb = Epi::PERM ? ((R & ~31) + perm32(R & 31)) : R;
        voffA[i] = (unsigned)(R * g.lda + C) * 2u; voffB[i] = (unsigned)(Rb * g.ldb + C) * 2u; }
    const size_t kstep = (size_t)(BK * 2);
    const size_t hstepA = (size_t)HALF * g.lda * 2, hstepB = (size_t)HALF * g.ldb * 2;
    const size_t tstepA = 2 * hstepA, tstepB = 2 * hstepB;
    const unsigned ldsw = (unsigned)wid * 1024u;
    const int aoff = lds_byte(wr * 64 + fr, fq * 8), boff = lds_byte(wc * 32 + fr, fq * 8);
#define PG8_SA(b, h) (((b) * 2 + (h)) * HTB)
#define PG8_SB(b, h) ((4 + (b) * 2 + (h)) * HTB)
#define PG8_STAGE(bufoff, gbase, voff) do { _Pragma("unroll") for (int _i = 0; _i < 2; ++_i) \
        __builtin_amdgcn_global_load_lds((const unsigned*)((const char*)(gbase) + (voff)[_i]), (LAS unsigned*)(lds + (bufoff) + ldsw + _i * 8192), 16, 0, 0); } while (0)
#define PG8_LDA(dst, b, h) do { _Pragma("unroll") for (int m = 0; m < 4; ++m) _Pragma("unroll") for (int k = 0; k < 2; ++k) dst[m][k] = *(const LAS bf16x8*)(lds + PG8_SA(b, h) + aoff + m * 2048 + k * 1024); } while (0)
#define PG8_LDB(dst, b, h) do { _Pragma("unroll") for (int n = 0; n < 2; ++n) _Pragma("unroll") for (int k = 0; k < 2; ++k) dst[n][k] = *(const LAS bf16x8*)(lds + PG8_SB(b, h) + boff + n * 2048 + k * 1024); } while (0)
#define PG8_MMA(ai, bj, At, Bt) do { __builtin_amdgcn_s_setprio(1); _Pragma("unroll") for (int m = 0; m < 4; ++m) _Pragma("unroll") for (int n = 0; n < 2; ++n) _Pragma("unroll") for (int k = 0; k < 2; ++k) \
        acc[ai][bj][m][n] = __builtin_amdgcn_mfma_f32_16x16x32_bf16(Bt[n][k], At[m][k], acc[ai][bj][m][n], 0, 0, 0); __builtin_amdgcn_s_setprio(0); } while (0)
#define PG8_WAIT_V(n) asm volatile("s_waitcnt vmcnt(" #n ")" ::: "memory")
#define PG8_WAIT_L(n) asm volatile("s_waitcnt lgkmcnt(" #n ")" ::: "memory")
#define PG8_BAR __builtin_amdgcn_s_barrier()
#define PG8_SCHED __builtin_amdgcn_sched_barrier(0)
    Unit cur, nxt; int ui = 0;
    if (!S.next(0, cur)) return;
    f32x4 acc[2][2][4][2];
#pragma unroll
    for (int a = 0; a < 2; ++a)
#pragma unroll
        for (int b = 0; b < 2; ++b)
#pragma unroll
            for (int m = 0; m < 4; ++m)
#pragma unroll
                for (int n = 0; n < 2; ++n) acc[a][b][m][n] = (f32x4){0.f, 0.f, 0.f, 0.f};
    bf16x8 At[4][2], B0[2][2], B1[2][2];
    const char* cA = (const char*)g.A + (size_t)cur.pm * tstepA + (size_t)cur.kt0 * kstep; const char* cB = (const char*)g.Bt + (size_t)cur.pn * tstepB + (size_t)cur.kt0 * kstep;
    PG8_STAGE(PG8_SB(0, 0), cB, voffB); PG8_STAGE(PG8_SB(0, 1), cB + hstepB, voffB); PG8_STAGE(PG8_SA(0, 0), cA, voffA); PG8_STAGE(PG8_SA(0, 1), cA + hstepA, voffA);
    if (wr == 1) PG8_BAR;
    PG8_WAIT_V(2); PG8_BAR;
    PG8_STAGE(PG8_SB(1, 0), cB + kstep, voffB); PG8_STAGE(PG8_SA(1, 0), cA + kstep, voffA); PG8_STAGE(PG8_SB(1, 1), cB + hstepB + kstep, voffB);
    PG8_WAIT_V(6); PG8_BAR;
    for (;;) {
        const bool has_next = S.next(ui + 1, nxt);
        const char* nA = has_next ? (const char*)g.A + (size_t)nxt.pm * tstepA + (size_t)nxt.kt0 * kstep : cA; const char* nB = has_next ? (const char*)g.Bt + (size_t)nxt.pn * tstepB + (size_t)nxt.kt0 * kstep : cB;
        const int nt = cur.nk;
        for (int t = 0; t < nt; t += 2) {
            const bool last = (t == nt - 2);
            const char* a1 = cA + (size_t)(t + 1) * kstep;
            const char* a2 = last ? nA : cA + (size_t)(t + 2) * kstep; const char* b2 = last ? nB : cB + (size_t)(t + 2) * kstep;
            const char* a3 = a2 + kstep; const char* b3 = b2 + kstep;
            PG8_LDB(B0, 0, 0); PG8_LDB(B1, 0, 1); PG8_SCHED; PG8_LDA(At, 0, 0); PG8_STAGE(PG8_SA(1, 1), a1 + hstepA, voffA);
            PG8_WAIT_V(8); PG8_WAIT_L(0); PG8_BAR; PG8_MMA(0, 0, At, B0); PG8_MMA(0, 1, At, B1); PG8_BAR; PG8_SCHED;
            PG8_LDA(At, 0, 1); PG8_STAGE(PG8_SB(0, 0), b2, voffB); PG8_STAGE(PG8_SB(0, 1), b2 + hstepB, voffB); PG8_STAGE(PG8_SA(0, 0), a2, voffA);
            PG8_WAIT_V(8); PG8_WAIT_L(0); PG8_BAR; PG8_MMA(1, 0, At, B0); PG8_MMA(1, 1, At, B1); PG8_BAR; PG8_SCHED;
            PG8_LDB(B0, 1, 0); PG8_LDB(B1, 1, 1); PG8_SCHED; PG8_LDA(At, 1, 0); PG8_STAGE(PG8_SA(0, 1), a2 + hstepA, voffA);
            PG8_WAIT_V(8); PG8_WAIT_L(0); PG8_BAR; PG8_MMA(0, 0, At, B0); PG8_MMA(0, 1, At, B1); PG8_BAR; PG8_SCHED;
            PG8_LDA(At, 1, 1); PG8_STAGE(PG8_SB(1, 0), b3, voffB); PG8_STAGE(PG8_SB(1, 1), b3 + hstepB, voffB); PG8_STAGE(PG8_SA(1, 0), a3, voffA);
            PG8_WAIT_V(8); PG8_WAIT_L(0); PG8_BAR; PG8_MMA(1, 0, At, B0); PG8_MMA(1, 1, At, B1); PG8_BAR; PG8_SCHED;
        }
        if (wr == 0) PG8_BAR;
        E(acc, cur, wr, wc, fr, fq);
        if (!has_next) break;
#pragma unroll
        for (int a = 0; a < 2; ++a)
#pragma unroll
            for (int b = 0; b < 2; ++b)
#pragma unroll
                for (int m = 0; m < 4; ++m)
#pragma unroll
                    for (int n = 0; n < 2; ++n) acc[a][b][m][n] = (f32x4){0.f, 0.f, 0.f, 0.f};
        cur = nxt; cA = nA; cB = nB; ++ui;
        if (wr == 1) PG8_BAR;
    }
    PG8_WAIT_V(0);
    PG8_BAR;
#undef PG8_SA
#undef PG8_SB
#undef PG8_STAGE
#undef PG8_LDA
#undef PG8_LDB
#undef PG8_MMA
#undef PG8_WAIT_V
#undef PG8_WAIT_L
#undef PG8_BAR
#undef PG8_SCHED
}
}

__device__ __forceinline__ void adaln_item(PP p, int it, unsigned char* shm, int tid_) {
    const int tid = tid_, lane = tid & 63, w = __builtin_amdgcn_readfirstlane(tid >> 6), fr = lane & 15, fq = lane >> 4;
    const int l = it / 96, cb = it % 96, nb0 = cb * 64, n0 = nb0 + (w & 3) * 16, rh = w >> 2;
    bf16_t* SC = (bf16_t*)shm;
    bf16_t* WS_ = (bf16_t*)(shm + 144 * 136 * 2);
    const float* W = p->in[I_WADA] + (size_t)l * D * NMOD;
    const float* cP = p->in[I_CP]; const float* cS = p->in[I_CS];
    f32x4 acc[5];
#pragma unroll
    for (int i = 0; i < 5; ++i) acc[i] = (f32x4){0.f, 0.f, 0.f, 0.f};
    const int kk4 = (lane & 31) * 4, rsub = lane >> 5;
    const int wc4 = (tid & 15) * 4, wk = tid >> 4;
    for (int kc = 0; kc < 8; ++kc) {
        f32x4 cv[9], wq[4];
#pragma unroll
        for (int i = 0; i < 4; ++i) wq[i] = *(const f32x4*)(W + (size_t)(kc * 128 + wk + 32 * i) * NMOD + nb0 + wc4);
#pragma unroll
        for (int ps = 0; ps < 9; ++ps) { const int m = ps * 16 + w * 2 + rsub;
            cv[ps] = (m < NBATCH) ? *(const f32x4*)((m < 8 ? cP + m * D : cS + (m - 8) * D) + kc * 128 + kk4) : (f32x4){0.f, 0.f, 0.f, 0.f}; }
        __syncthreads();
#pragma unroll
        for (int i = 0; i < 4; ++i) { u32x2 pk; pk.x = cvt_pk_bf16(wq[i][0], wq[i][1]); pk.y = cvt_pk_bf16(wq[i][2], wq[i][3]);
            unsigned* d = (unsigned*)(WS_ + (wk + 32 * i) * 66 + wc4); d[0] = pk.x; d[1] = pk.y; }
#pragma unroll
        for (int ps = 0; ps < 9; ++ps) { const int m = ps * 16 + w * 2 + rsub; f32x4 x = cv[ps], y;
#pragma unroll
            for (int i = 0; i < 4; ++i) y[i] = x[i] * __builtin_amdgcn_rcpf(1.0f + __expf(-x[i]));
            u32x2 pk; pk.x = cvt_pk_bf16(y[0], y[1]); pk.y = cvt_pk_bf16(y[2], y[3]);
            *(u32x2*)(SC + m * 136 + kk4) = pk; }
        __syncthreads();
#pragma unroll
        for (int ks = 0; ks < 4; ++ks) {
            bf16x8 wf;
#pragma unroll
            for (int j = 0; j < 8; ++j) wf[j] = (short)WS_[(ks * 32 + fq * 8 + j) * 66 + (w & 3) * 16 + fr];
#pragma unroll
            for (int i = 0; i < 5; ++i) { const int mt = rh * 5 + i;
                if (mt < 9) { const bf16x8 af = *(const bf16x8*)(SC + (mt * 16 + fr) * 136 + ks * 32 + fq * 8); acc[i] = __builtin_amdgcn_mfma_f32_16x16x32_bf16(wf, af, acc[i], 0, 0, 0); } }
        }
    }
    float* MOD = (float*)(p->ws + WS_MOD);
    const float* bias = p->in[I_BADA] + l * NMOD;
#pragma unroll
    for (int i = 0; i < 5; ++i) { const int mt = rh * 5 + i, m = mt * 16 + fr;
        if (mt < 9 && m < NBATCH) { const int n = n0 + 4 * fq; const f32x4 bv = *(const f32x4*)(bias + n); *(f32x4*)(MOD + ((size_t)l * NBATCH + m) * NMOD + n) = acc[i] + bv; } }
}

__device__ __forceinline__ void convert_item(PP p, int r, unsigned char* shm, int tid_) {
    const int tid = tid_;
    const int l = r / 752; r %= 752;
    const float* W; int K, N; size_t wto; bool uvperm = false;
    if (r < 160) { W = p->in[I_WIN] + (size_t)l * D * NIN; K = D; N = NIN; wto = WT_IN; }
    else if (r < 224) { r -= 160; W = p->in[I_WOUT] + (size_t)l * D * D; K = D; N = D; wto = WT_OUT; }
    else if (r < 576) { r -= 224; W = p->in[I_WUP] + (size_t)l * D * NUP; K = D; N = NUP; wto = WT_UP; uvperm = true; }
    else { r -= 576; W = p->in[I_WDN] + (size_t)l * DFF * D; K = DFF; N = D; wto = WT_DN; }
    bf16_t* WT = (bf16_t*)(p->ws + WS_WT) + (size_t)l * LAYER_WT + wto;
    const int nb = N / 256, kb = r / nb, nbk = r % nb, k0 = kb * 64, n0 = nbk * 256;
    float* T = (float*)shm;
    __syncthreads();
#pragma unroll
    for (int i = 0; i < 8; ++i) { const int idx = i * 512 + tid, kk = idx >> 6, c4 = idx & 63;
        const f32x4 v = *(const f32x4*)(W + (size_t)(k0 + kk) * N + n0 + c4 * 4);
        float* t = T + kk * 257 + c4 * 4; t[0] = v[0]; t[1] = v[1]; t[2] = v[2]; t[3] = v[3]; }
    __syncthreads();
#pragma unroll
    for (int ps = 0; ps < 4; ++ps) { const int n = ps * 64 + (tid >> 3), kg = tid & 7; float f[8];
#pragma unroll
        for (int j = 0; j < 8; ++j) f[j] = T[(kg * 8 + j) * 257 + n];
        int nd = n0 + n; if (uvperm) { const int mm = nd < DFF ? nd : nd - DFF; nd = (mm >> 7) * 256 + (nd < DFF ? 0 : 128) + (mm & 127); }
        *(u32x4*)(WT + (size_t)nd * K + k0 + kg * 8) = pack8(f); }
}

__device__ __forceinline__ void p0_phase(PP p, unsigned char* shm, int tid_, int bid_, int G_) {
    constexpr int N_ADA = 192, N_CV = 1504;
    for (int it = bid_; it < N_ADA + N_CV; it += G_) {
        if (it < N_ADA) adaln_item(p, it, shm, tid_); else convert_item(p, it - N_ADA, shm, tid_);
    }
}

__device__ __forceinline__ f32x4 ld4_bf16(const bf16_t* p) { const u32x2 w = *(const u32x2*)p; return (f32x4){bf_lo(w.x), bf_hi(w.x), bf_lo(w.y), bf_hi(w.y)}; }
template <bool FINAL>
__device__ __forceinline__ void norm_phase(const float* xpf, const bf16_t* xpb, const float* xsf, const bf16_t* xsb, const float* g, const float* mod, int sh_off, int sc_off, bf16_t* HN, float* Yf, bf16_t* XBw,
                                           const bf16_t* part, int sp, const float* pgate, int tid_, int bid_, int G_) {
    const int lane = tid_ & 63, w = tid_ >> 6;
    const int gw = bid_ * 8 + w, NW = G_ * 8;
    const int wpb = NW >> 3, pb = gw / wpb, pi0 = gw - pb * wpb, npr = (2048 - pi0 + wpb - 1) / wpb, nrow = npr + (gw < MS ? (MS - gw + NW - 1) / NW : 0);
#define ROW(i) ((i) < npr ? pb * 2048 + pi0 + (i) * wpb : MP + gw + ((i) - npr) * NW)
    f32x4 ms[4], mh[4];
#pragma unroll
    for (int j = 0; j < 4; ++j) { ms[j] = *(const f32x4*)(g + 4 * lane + 256 * j); mh[j] = (f32x4){0.f, 0.f, 0.f, 0.f}; }
    int bcur = -1;
    constexpr int NR = 3;
    for (int ib = 0; ib < nrow; ib += NR) {
        f32x4 v[NR][4];
#pragma unroll
        for (int q = 0; q < NR; ++q) { const int R = ROW(ib + q);
            if (ib + q < nrow) {
                const bool smp = R >= MP; const size_t ro = (size_t)(smp ? R - MP : R) * D + 4 * lane;
                const float* xf = smp ? xsf : xpf; const bf16_t* xb = smp ? xsb : xpb;
                if (xf) {
#pragma unroll
                    for (int j = 0; j < 4; ++j) v[q][j] = *(const f32x4*)(xf + ro + 256 * j); }
                else {
#pragma unroll
                    for (int j = 0; j < 4; ++j) v[q][j] = ld4_bf16(xb + ro + 256 * j); } }
            else {
#pragma unroll
                for (int j = 0; j < 4; ++j) v[q][j] = (f32x4){0.f, 0.f, 0.f, 0.f}; } }
#pragma unroll
        for (int q = 0; q < NR; ++q) { const int R = ROW(ib + q);
            if (part && ib + q < nrow && R >= MP) {
                const float* pg = pgate + (size_t)batch_of(R) * NMOD; const bf16_t* pr = part + (size_t)(R - MP) * D;
#pragma unroll
                for (int j = 0; j < 4; ++j) { const int c = 4 * lane + 256 * j; f32x4 a = (f32x4){0.f, 0.f, 0.f, 0.f};
                    for (int ch = 0; ch < sp; ++ch) a += ld4_bf16(pr + (size_t)ch * MS * D + c);
                    v[q][j] += *(const f32x4*)(pg + c) * a; } } }
#pragma unroll
        for (int q = 0; q < NR; ++q) { const int R = ROW(ib + q);
            if (ib + q < nrow) {
                float ss = 0.f;
#pragma unroll
                for (int j = 0; j < 4; ++j) ss += (v[q][j][0] * v[q][j][0] + v[q][j][1] * v[q][j][1]) + (v[q][j][2] * v[q][j][2] + v[q][j][3] * v[q][j][3]);
                ss = wave_sum(ss);
                const float rstd = __builtin_amdgcn_rsqf(ss * (1.0f / D) + 1e-6f);
                if (FINAL) {
#pragma unroll
                    for (int j = 0; j < 4; ++j) *(f32x4*)(Yf + (size_t)R * D + 4 * lane + 256 * j) = v[q][j] * rstd * ms[j];
                } else {
                    const int b = batch_of(R);
                    if (b != bcur) { bcur = b; const float* mb = mod + (size_t)b * NMOD;
#pragma unroll
                        for (int j = 0; j < 4; ++j) { const int c = 4 * lane + 256 * j; ms[j] = *(const f32x4*)(g + c) * (*(const f32x4*)(mb + sc_off + c) + 1.0f); mh[j] = *(const f32x4*)(mb + sh_off + c); } }
                    if (part && R >= MP) {
#pragma unroll
                        for (int j = 0; j < 4; ++j) { u32x2 wv; wv.x = cvt_pk_bf16(v[q][j][0], v[q][j][1]); wv.y = cvt_pk_bf16(v[q][j][2], v[q][j][3]); *(u32x2*)(XBw + (size_t)R * D + 4 * lane + 256 * j) = wv; } }
#pragma unroll
                    for (int j = 0; j < 4; ++j) { const f32x4 o = v[q][j] * rstd * ms[j] + mh[j];
                        u32x2 wv; wv.x = cvt_pk_bf16(o[0], o[1]); wv.y = cvt_pk_bf16(o[2], o[3]);
                        *(u32x2*)(HN + (size_t)R * D + 4 * lane + 256 * j) = wv; }
                }
            } }
    }
#undef ROW
}

constexpr int S1_CONST_BYTES = 11 * 512 * 4;
constexpr int S1_XCB = 0, S1_XCF = 2304, S1_BB = 2304 + 4352, S1_XLS = 11008, S1_ZS = 11008 + 2736, S1_WREG = 16384;
static_assert(S1_CONST_BYTES + 8 * S1_WREG <= LDS_BARW, "scan phase LDS");
__device__ __forceinline__ void s1_phase(PP p, int l, unsigned char* shm, int tid_, int bid_, int G_) {
    const int tid = tid_, lane = tid & 63, h = tid >> 6, fr = lane & 15, fq = lane >> 4;
    float* cst = (float*)shm;
    float* c_cw = cst, *c_cb = cst + 2048, *c_ba = cst + 2560, *c_bx = cst + 3072, *c_sp = cst + 3584, *c_scw = cst + 4096;
    __syncthreads();
    for (int i = tid; i < 2048; i += 512) c_cw[i] = p->in[I_LCW][l * 2048 + i];
    { const int i = tid; c_cb[i] = p->in[I_LCB][l * 512 + i]; c_ba[i] = p->in[I_BA][l * 512 + i]; c_bx[i] = p->in[I_BX][l * 512 + i];
      const float x = -p->in[I_LAM][l * 512 + i]; c_sp[i] = 8.0f * (fmaxf(x, 0.f) + log1pf(__expf(-fabsf(x)))); }
    for (int i = tid; i < 1536; i += 512) c_scw[i] = p->in[I_SCW][l * 1536 + i];
    __syncthreads();
    unsigned char* wreg = shm + S1_CONST_BYTES + h * S1_WREG;
    bf16_t* XCb = (bf16_t*)(wreg + S1_XCB);
    float* XCf = (float*)(wreg + S1_XCF);
    float* BBf = (float*)(wreg + S1_BB);
    bf16x8 wfa[4][2], wfx[4][2];
    {
        const float* Wa = p->in[I_WA] + ((size_t)l * 8 + h) * 4096; const float* Wx = p->in[I_WX] + ((size_t)l * 8 + h) * 4096;
#pragma unroll
        for (int nt = 0; nt < 4; ++nt)
#pragma unroll
            for (int ks = 0; ks < 2; ++ks) { float fa[8], fx[8];
#pragma unroll
                for (int j = 0; j < 8; ++j) { const int k = ks * 32 + fq * 8 + j, n = nt * 16 + fr; fa[j] = Wa[k * 64 + n]; fx[j] = Wx[k * 64 + n]; }
                wfa[nt][ks] = as_bf16x8(pack8(fa)); wfx[nt][ks] = as_bf16x8(pack8(fx)); }
    }
    const bf16_t* PROJ = (const bf16_t*)(p->ws + WS_PROJ);
    bf16_t* MIX = (bf16_t*)(p->ws + WS_HN);
    bf16_t* VB = (bf16_t*)(p->ws + WS_VB);
    float* AGG = (float*)(p->ws + WS_AGG);
    const float* st_h = p->in[I_SH] + (size_t)l * 128 * DH;
    const float* st_lc = p->in[I_SLC] + (size_t)l * 128 * 3 * DH;
    const float* st_sc = p->in[I_SSC] + (size_t)l * 128 * 2 * DH;
    float* out = p->out;
    bf16_t* XLs = (bf16_t*)(wreg + S1_XLS);
    bf16_t* Zs = (bf16_t*)(wreg + S1_ZS);
    const int npt = bid_ < 256 ? (256 - bid_ + G_ - 1) / G_ : 0, nst = bid_ < 64 ? (64 - bid_ + G_ - 1) / G_ : 0;
    const int nit = npt * 4 + nst;
    const int r8 = lane >> 3, cg8 = (lane & 7) * 8, c0 = h * 64 + cg8;
    float hcur = 0.f, Pcur = 1.f;
    u32x4 pxl[2], pcs[2], phs[2], phx, phh; bf16_t pgl[16];
#define S1_R0(it_) ((it_) >= npt * 4 ? MP + (bid_ + ((it_) - npt * 4) * G_) * 16 : (bid_ + ((it_) >> 2) * G_) * 64 + ((it_) & 3) * 16)
#define S1_ISSUE_MAIN(it_) do { const int R0n = S1_R0(it_); const bool smpn = (it_) >= npt * 4; \
        _Pragma("unroll") for (int s_ = 0; s_ < 2; ++s_) { const bf16_t* pr = PROJ + (size_t)(R0n + s_ * 8 + r8) * NIN + c0; \
            pxl[s_] = *(const u32x4*)pr; pcs[s_] = *(const u32x4*)(pr + 1536); phs[s_] = *(const u32x4*)(pr + 2048); } \
        phx = (u32x4){0u, 0u, 0u, 0u}; phh = phx; \
        if (!smpn && (R0n & 2047) != 0) { if (lane < 24) phx = *(const u32x4*)(PROJ + (size_t)(R0n - 3 + r8) * NIN + c0); \
            else if (lane < 40) { const bf16_t* pr = PROJ + (size_t)(R0n - 2 + (r8 - 3)) * NIN + c0; phx = *(const u32x4*)(pr + 1536); phh = *(const u32x4*)(pr + 2048); } } } while (0)
#define S1_ISSUE_GL(it_) do { const int R0n = S1_R0(it_); _Pragma("unroll") for (int row_ = 0; row_ < 16; ++row_) pgl[row_] = PROJ[(size_t)(R0n + row_) * NIN + 512 + h * 64 + lane]; } while (0)
    if (nit > 0) { S1_ISSUE_MAIN(0); S1_ISSUE_GL(0); }
    {
#pragma unroll 1
        for (int it = 0; it < nit; ++it) {
            const bool smp = it >= npt * 4;
            const int ti = bid_ + (it >> 2) * G_, mt = smp ? 0 : (it & 3);
            const int R0 = S1_R0(it);
            if (!smp && mt == 0) { hcur = 0.f; Pcur = 1.f; }
            float xo[2][8], zo[2][8];
#pragma unroll
            for (int s = 0; s < 2; ++s) { const int row = s * 8 + r8; float cv[8], hv[8];
                unpack8(pxl[s], xo[s]); unpack8(pcs[s], cv); unpack8(phs[s], hv);
#pragma unroll
                for (int j = 0; j < 8; ++j) zo[s][j] = cv[j] * hv[j];
                *(u32x4*)(XLs + (3 + row) * 72 + cg8) = pxl[s]; *(u32x4*)(Zs + (2 + row) * 72 + cg8) = pack8(zo[s]); }
            if (lane < 24) *(u32x4*)(XLs + r8 * 72 + cg8) = phx;
            else if (lane < 40) { float cv[8], hv[8], zz[8]; unpack8(phx, cv); unpack8(phh, hv);
#pragma unroll
                for (int j = 0; j < 8; ++j) zz[j] = cv[j] * hv[j];
                *(u32x4*)(Zs + (r8 - 3) * 72 + cg8) = pack8(zz); }
            WAVE_LDS_SYNC();
#pragma unroll
            for (int s = 0; s < 2; ++s) {
                const int row = s * 8 + r8, R = R0 + row;
                int t, T, bsm = 0, bq;
                if (smp) { const int si = R - MP; bsm = si >> 3; t = si & 7; T = 8; bq = bsm; } else { t = R & 2047; T = 2048; bq = R >> 11; }
                float xc[8];
                { const f32x4 b0 = *(const f32x4*)(c_cb + c0), b1 = *(const f32x4*)(c_cb + c0 + 4), w0 = *(const f32x4*)(c_cw + 3 * 512 + c0), w1 = *(const f32x4*)(c_cw + 3 * 512 + c0 + 4);
#pragma unroll
                  for (int j = 0; j < 4; ++j) { xc[j] = b0[j] + w0[j] * xo[s][j]; xc[j + 4] = b1[j] + w1[j] * xo[s][j + 4]; } }
#pragma unroll
                for (int k = 0; k < 3; ++k) {
                    const int tt = t - 3 + k; float xv[8];
                    if (smp && tt < 0) { const float* sp = st_lc + ((size_t)bsm * 3 + (3 + tt)) * DH + c0; const f32x4 a0 = *(const f32x4*)sp, a1 = *(const f32x4*)(sp + 4); xv[0] = a0[0]; xv[1] = a0[1]; xv[2] = a0[2]; xv[3] = a0[3]; xv[4] = a1[0]; xv[5] = a1[1]; xv[6] = a1[2]; xv[7] = a1[3]; }
                    else unpack8(*(const u32x4*)(XLs + (row + k) * 72 + cg8), xv);
                    const f32x4 w0 = *(const f32x4*)(c_cw + k * 512 + c0), w1 = *(const f32x4*)(c_cw + k * 512 + c0 + 4);
                    xc[0] += w0[0] * xv[0]; xc[1] += w0[1] * xv[1]; xc[2] += w0[2] * xv[2]; xc[3] += w0[3] * xv[3]; xc[4] += w1[0] * xv[4]; xc[5] += w1[1] * xv[5]; xc[6] += w1[2] * xv[6]; xc[7] += w1[3] * xv[7];
                }
                *(u32x4*)(XCb + row * 72 + cg8) = pack8(xc);
                *(f32x4*)(XCf + row * 68 + cg8) = (f32x4){xc[0], xc[1], xc[2], xc[3]}; *(f32x4*)(XCf + row * 68 + cg8 + 4) = (f32x4){xc[4], xc[5], xc[6], xc[7]};
                if (t >= T - 3) { float* o = out + (smp ? O_NLC_S : O_NLC_P) + (((size_t)l * (smp ? 128 : 8) + bq) * 3 + (t - (T - 3))) * DH + c0;
                    *(f32x4*)o = (f32x4){xo[s][0], xo[s][1], xo[s][2], xo[s][3]}; *(f32x4*)(o + 4) = (f32x4){xo[s][4], xo[s][5], xo[s][6], xo[s][7]}; }
                float zc[8];
                { const f32x4 w0 = *(const f32x4*)(c_scw + 2 * 512 + c0), w1 = *(const f32x4*)(c_scw + 2 * 512 + c0 + 4);
#pragma unroll
                  for (int j = 0; j < 4; ++j) { zc[j] = w0[j] * zo[s][j]; zc[j + 4] = w1[j] * zo[s][j + 4]; } }
#pragma unroll
                for (int k = 0; k < 2; ++k) {
                    const int tt = t - 2 + k; float zv[8];
                    if (smp && tt < 0) { const float* sp = st_sc + ((size_t)bsm * 2 + (2 + tt)) * DH + c0; const f32x4 a0 = *(const f32x4*)sp, a1 = *(const f32x4*)(sp + 4); zv[0] = a0[0]; zv[1] = a0[1]; zv[2] = a0[2]; zv[3] = a0[3]; zv[4] = a1[0]; zv[5] = a1[1]; zv[6] = a1[2]; zv[7] = a1[3]; }
                    else unpack8(*(const u32x4*)(Zs + (row + k) * 72 + cg8), zv);
                    const f32x4 w0 = *(const f32x4*)(c_scw + k * 512 + c0), w1 = *(const f32x4*)(c_scw + k * 512 + c0 + 4);
                    zc[0] += w0[0] * zv[0]; zc[1] += w0[1] * zv[1]; zc[2] += w0[2] * zv[2]; zc[3] += w0[3] * zv[3]; zc[4] += w1[0] * zv[4]; zc[5] += w1[1] * zv[5]; zc[6] += w1[2] * zv[6]; zc[7] += w1[3] * zv[7];
                }
                { float so[8], bo[8]; unpack8(*(const u32x4*)(PROJ + (size_t)R * NIN + 1024 + c0), bo);
#pragma unroll
                  for (int j = 0; j < 8; ++j) so[j] = bo[j] * zc[j];
                  *(u32x4*)(MIX + (size_t)R * D + 512 + c0) = pack8(so); }
                if (t >= T - 2) { float* o = out + (smp ? O_NSC_S : O_NSC_P) + (((size_t)l * (smp ? 128 : 8) + bq) * 2 + (t - (T - 2))) * DH + c0;
                    *(f32x4*)o = (f32x4){zo[s][0], zo[s][1], zo[s][2], zo[s][3]}; *(f32x4*)(o + 4) = (f32x4){zo[s][4], zo[s][5], zo[s][6], zo[s][7]}; }
            }
            if (it + 1 < nit) S1_ISSUE_MAIN(it + 1);
            WAVE_LDS_SYNC();
            f32x4 ga[4], gx[4];
            {
                const bf16x8 af0 = *(const bf16x8*)(XCb + fr * 72 + fq * 8), af1 = *(const bf16x8*)(XCb + fr * 72 + 32 + fq * 8);
#pragma unroll
                for (int nt = 0; nt < 4; ++nt) {
                    f32x4 a = (f32x4){0.f, 0.f, 0.f, 0.f}, x = (f32x4){0.f, 0.f, 0.f, 0.f};
                    a = __builtin_amdgcn_mfma_f32_16x16x32_bf16(wfa[nt][0], af0, a, 0, 0, 0); a = __builtin_amdgcn_mfma_f32_16x16x32_bf16(wfa[nt][1], af1, a, 0, 0, 0);
                    x = __builtin_amdgcn_mfma_f32_16x16x32_bf16(wfx[nt][0], af0, x, 0, 0, 0); x = __builtin_amdgcn_mfma_f32_16x16x32_bf16(wfx[nt][1], af1, x, 0, 0, 0);
                    ga[nt] = a; gx[nt] = x;
                }
            }
#pragma unroll
            for (int nt = 0; nt < 4; ++nt) {
                const int cl = nt * 16 + 4 * fq, cgl = h * 64 + cl;
                const f32x4 xv = *(const f32x4*)(XCf + fr * 68 + cl), ba = *(const f32x4*)(c_ba + cgl), bx = *(const f32x4*)(c_bx + cgl), sp = *(const f32x4*)(c_sp + cgl);
                f32x4 av, bv;
#pragma unroll
                for (int i = 0; i < 4; ++i) { const float r = sigmoidf_(ga[nt][i] + ba[i]), ig = sigmoidf_(gx[nt][i] + bx[i]);
                    const float la = -sp[i] * r, a = __expf(la), mult = __builtin_amdgcn_sqrtf(fmaxf(1.0f - a * a, 0.f));
                    av[i] = a; bv[i] = mult * ig * xv[i]; }
                *(f32x4*)(XCf + fr * 68 + cl) = av; *(f32x4*)(BBf + fr * 68 + cl) = bv;
            }
            WAVE_LDS_SYNC();
            {
                const int c = h * 64 + lane;
#pragma unroll
                for (int row = 0; row < 16; ++row) {
                    const int R = R0 + row;
                    const float a = XCf[row * 68 + lane], b = BBf[row * 68 + lane], gg = gelu_tanh(bf2f(pgl[row]));
                    if (smp && (row & 7) == 0) hcur = st_h[(size_t)((R - MP) >> 3) * DH + c];
                    hcur = a * hcur + b; Pcur *= a;
                    if (smp) { MIX[(size_t)R * D + c] = f2bf(hcur * gg); if ((row & 7) == 7) out[O_NH_S + ((size_t)l * 128 + ((R - MP) >> 3)) * DH + c] = hcur; }
                    else { MIX[(size_t)R * D + c] = f2bf(hcur * gg); VB[(size_t)R * DH + c] = f2bf(Pcur * gg); }
                }
            }
            if (it + 1 < nit) S1_ISSUE_GL(it + 1);
            WAVE_LDS_SYNC();
            if (!smp && mt == 3) { const int c = h * 64 + lane; AGG[((size_t)ti * 2 + 0) * DH + c] = Pcur; AGG[((size_t)ti * 2 + 1) * DH + c] = hcur; }
        }
    }
#undef S1_R0
#undef S1_ISSUE_MAIN
#undef S1_ISSUE_GL
}

__device__ __forceinline__ void s2_phase(PP p, int l, unsigned char* shm, int tid_, int bid_, int G_) {
    const int tid = tid_;
    float* hin = (float*)shm;
    const float* AGG = (const float*)(p->ws + WS_AGG);
    const bf16_t* VB = (const bf16_t*)(p->ws + WS_VB);
    bf16_t* MIX = (bf16_t*)(p->ws + WS_HN);
    for (int ti = bid_; ti < 256; ti += G_) {
        const int b = ti >> 5, jn = ti & 31, c = tid;
        __syncthreads();
        float hh = 0.f;
        for (int jj = 0; jj < jn; ++jj) { const float P = AGG[((size_t)(b * 32 + jj) * 2 + 0) * DH + c], H = AGG[((size_t)(b * 32 + jj) * 2 + 1) * DH + c]; hh = P * hh + H; }
        hin[c] = hh;
        if (jn == 31) { const float P = AGG[((size_t)ti * 2 + 0) * DH + c], H = AGG[((size_t)ti * 2 + 1) * DH + c]; p->out[O_NH_P + ((size_t)l * 8 + b) * DH + c] = P * hh + H; }
        __syncthreads();
#pragma unroll 2
        for (int i = 0; i < 8; ++i) { const int idx = i * 512 + tid, row = idx >> 6, c0 = (idx & 63) * 8; const size_t R = (size_t)ti * 64 + row;
            float u[8], v[8], o[8]; unpack8(*(const u32x4*)(MIX + R * D + c0), u); unpack8(*(const u32x4*)(VB + R * DH + c0), v);
#pragma unroll
            for (int j = 0; j < 8; ++j) o[j] = u[j] + v[j] * hin[c0 + j];
            *(u32x4*)(MIX + R * D + c0) = pack8(o); }
    }
}

__device__ __forceinline__ void ffn_fixup(PP p, int l, const pg8::StaticOrder& S, int tid_) {
    const float* UH = (const float*)(p->ws + WS_UH); const float* UF = (const float*)(p->ws + WS_UF); bf16_t* ACT = (bf16_t*)(p->ws + WS_ACT);
    const float* fcw = p->in[I_FCW] + (size_t)l * 3 * DFF;
    pg8::Unit u;
    for (int i = 0; S.next(i, u); ++i) {
        const int pm = u.pm; if (pm >= 64 || (pm & 7) == 0) continue;
        float u0[11], vv[11], h1[11], h0[11], uf0[11];
#pragma unroll
        for (int i = 0; i < 11; ++i) { const int e = tid_ + i * 512, rr = e >= DFF ? 1 : 0, f = e - rr * DFF;
            u0[i] = UF[(size_t)(pm * 2 + rr) * NUP + f]; vv[i] = UF[(size_t)(pm * 2 + rr) * NUP + DFF + f];
            h1[i] = UH[(size_t)((pm - 1) * 2 + 1) * DFF + f]; h0[i] = UH[(size_t)((pm - 1) * 2) * DFF + f]; uf0[i] = UF[(size_t)(pm * 2) * NUP + f]; }
#pragma unroll
        for (int i = 0; i < 11; ++i) { const int e = tid_ + i * 512, rr = e >= DFF ? 1 : 0, f = e - rr * DFF;
            const float p1 = rr ? uf0[i] : h1[i], p2 = rr ? h1[i] : h0[i];
            ACT[(size_t)(pm * 256 + rr) * DFF + f] = f2bf(gelu_tanh(fcw[f] * p2 + fcw[DFF + f] * p1 + fcw[2 * DFF + f] * u0[i]) * vv[i]); }
    }
    asm volatile("s_waitcnt vmcnt(0)" ::: "memory");
    __syncthreads();
}

__device__ __forceinline__ void run_phase(PP p, int ph, unsigned char* shm, int rep_idx) {
    int tid_ = threadIdx.x, bid_ = blockIdx.x, G_ = gridDim.x;
    asm volatile("" : "+v"(tid_)); asm volatile("" : "+s"(bid_)); asm volatile("" : "+s"(G_));
    bf16_t* XB = (bf16_t*)(p->ws + WS_XB);
    bf16_t* HN = (bf16_t*)(p->ws + WS_HN);
    const float* MODb = (const float*)(p->ws + WS_MOD);
    bf16_t* WTb = (bf16_t*)(p->ws + WS_WT);
    if (ph == 0) { if (PMASK & 1) p0_phase(p, shm, tid_, bid_, G_); return; }
    const bf16_t* PART = (const bf16_t*)(p->ws + WS_PART);
    if (ph == NPHASE - 1) { if (PMASK & 2) norm_phase<true>(nullptr, XB, nullptr, XB + (size_t)MP * D, p->in[I_FG], nullptr, 0, 0, nullptr, p->out, nullptr, PART, SP_DN, MODb + (size_t)1 * NBATCH * NMOD + 5120, tid_, bid_, G_); return; }
    const int q = ph - 1, l = q / 8, s = q % 8;
    const float* mod = MODb + (size_t)l * NBATCH * NMOD;
    bf16_t* WT = WTb + (size_t)l * LAYER_WT;
    if (s == 0 || s == 5) { if (PMASK & 2) {
        if (s == 0) { if (l == 0) norm_phase<false>(p->in[I_XP], nullptr, p->in[I_XS], nullptr, p->in[I_N1G] + l * D, mod, 0, 1024, HN, nullptr, XB, nullptr, 0, nullptr, tid_, bid_, G_);
                      else norm_phase<false>(nullptr, XB, nullptr, XB + (size_t)MP * D, p->in[I_N1G] + l * D, mod, 0, 1024, HN, nullptr, XB, PART, SP_DN, mod - (size_t)NBATCH * NMOD + 5120, tid_, bid_, G_); }
        else norm_phase<false>(nullptr, XB, l == 0 ? p->in[I_XS] : nullptr, XB + (size_t)MP * D, p->in[I_N2G] + l * D, mod, 3072, 4096, HN, nullptr, XB, PART, SP_OUT, mod + 2048, tid_, bid_, G_); }
    } else if (s == 1) {
        pg8::Gemm g; pg8::EpiBf16 E;
        g.A = HN; g.Bt = WT + WT_IN; g.M = MT; g.N = NIN; g.K = D; g.lda = D; g.ldb = D; E.O = (bf16_t*)(p->ws + WS_PROJ); E.ldc = NIN;
        pg8::StaticOrder S; S.init(g.M, g.N, g.K, G_, bid_, 0);
        if (PMASK & 4) pg8::gemm_phase<pg8::EpiBf16>((LAS unsigned char*)shm, g, S, E, tid_);
    } else if (s == 6) {
        pg8::Gemm g; pg8::EpiFfn E;
        g.A = HN; g.Bt = WT + WT_UP; g.M = MT; g.N = NUP; g.K = D; g.lda = D; g.ldb = D;
        E.ACT = (bf16_t*)(p->ws + WS_ACT); E.UH = (float*)(p->ws + WS_UH); E.UF = (float*)(p->ws + WS_UF); E.fcw = p->in[I_FCW] + (size_t)l * 3 * DFF; E.st_fc = p->in[I_SFC] + (size_t)l * 128 * 2 * DFF;
        E.nfc_p = p->out + O_NFC_P + (size_t)l * 8 * 2 * DFF; E.nfc_s = p->out + O_NFC_S + (size_t)l * 128 * 2 * DFF; E.xch = (LAS float*)((LAS unsigned char*)shm + LDS_XCH);
        pg8::StaticOrder S; S.init(g.M, g.N, g.K, G_, bid_, 0);
        if (PMASK & 64) pg8::gemm_phase<pg8::EpiFfn>((LAS unsigned char*)shm, g, S, E, tid_);
    } else if (s == 4 || s == 7) {
        pg8::Gemm g; pg8::EpiRes E;
        if (s == 4) { g.A = HN; g.Bt = WT + WT_OUT; g.M = MT; g.N = D; g.K = D; g.lda = D; g.ldb = D; E.Xf = l == 0 ? p->in[I_XP] : nullptr; E.Xin = XB; E.X = XB; E.gate = mod + 2048; }
        else { g.A = (const bf16_t*)(p->ws + WS_ACT); g.Bt = WT + WT_DN; g.M = MT; g.N = D; g.K = DFF; g.lda = DFF; g.ldb = DFF; E.Xf = nullptr; E.Xin = XB; E.X = XB; E.gate = mod + 5120; }
        pg8::StaticOrder S; S.init(g.M, g.N, g.K, G_, bid_, s == 4 ? SP_OUT : SP_DN); E.nkt = S.nkt; E.part = (bf16_t*)(p->ws + WS_PART); E.scale = rep_idx > 0 ? 0.f : 1.f;
        if (s == 7) ffn_fixup(p, l, S, tid_);
        if (PMASK & 8) pg8::gemm_phase<pg8::EpiRes>((LAS unsigned char*)shm, g, S, E, tid_);
    } else if (s == 2) { if (PMASK & 16) s1_phase(p, l, shm, tid_, bid_, G_);
    } else { if (PMASK & 32) s2_phase(p, l, shm, tid_, bid_, G_); }
}

__global__ __launch_bounds__(512, 2) void mega(Params p_unused) {
    extern __shared__ __attribute__((aligned(16))) unsigned char shm[];
    cg::grid_group grid = cg::this_grid();
    PP pp = (PP)__builtin_amdgcn_kernarg_segment_ptr();
    const int ph_lo = pp->ph_lo, ph_hi = pp->ph_hi;
    const int rep_ph = pp->rep_ph, rep_n = pp->rep_n;
    if (ph_lo < 0) grid.sync();
    volatile LAS unsigned* st = (volatile LAS unsigned*)((LAS unsigned char*)shm + LDS_BARW);
    if (threadIdx.x == 0) { st[0] = 0u; st[1] = 0u; }
    __syncthreads();
    XcdBarrier xb = xcd_barrier_post((unsigned*)(pp->ws + WS_BAR), st);
    if (rep_ph == 1000) for (int r = 0; r < rep_n; ++r) xcd_barrier(xb);
    for (int ph = ph_lo; ph < ph_hi; ++ph) {
        const int reps = (ph == rep_ph) ? rep_n + 1 : 1;
        for (int r = 0; r < reps; ++r) {
            asm volatile("" : "+s"(pp));
            run_phase(pp, ph, shm, r);
            if (r + 1 < reps) xcd_barrier(xb);
        }
        if (ph + 1 < ph_hi) xcd_barrier(xb);
    }
}

extern "C" void kernel_launch(void* const* d_in, const int* in_sizes, int n_in, void* d_out, int out_size, void* d_ws, size_t ws_size, hipStream_t stream) {
    static int grid = 0;
    if (grid == 0) {
        if (n_in != 26 || (size_t)out_size != O_END || ws_size < WS_BAR + XCD_BAR_WORDS * 4) { fprintf(stderr, "kernel_launch: unexpected sizes n_in %d out %d ws %zu (need %zu)\n", n_in, out_size, ws_size, (size_t)WS_END); grid = -1; return; }
        int dev = 0, cus = 0, per_cu = 0;
        hipGetDevice(&dev); hipDeviceGetAttribute(&cus, hipDeviceAttributeMultiprocessorCount, dev);
        if (hipFuncSetAttribute((const void*)mega, hipFuncAttributeMaxDynamicSharedMemorySize, LDS_BYTES) != hipSuccess) { fprintf(stderr, "kernel_launch: hipFuncSetAttribute failed\n"); grid = -1; return; }
        if (hipOccupancyMaxActiveBlocksPerMultiprocessor(&per_cu, (const void*)mega, 512, LDS_BYTES) != hipSuccess || per_cu < 1) { fprintf(stderr, "kernel_launch: occupancy query failed (%d)\n", per_cu); (void)hipGetLastError(); per_cu = 1; }
        grid = cus * 1;
        if (per_cu < 1) grid = -1;
    }
    if (grid < 0) return;
    if (hipMemsetAsync((char*)d_ws + WS_BAR, 0, XCD_BAR_WORDS * 4, stream) != hipSuccess) { fprintf(stderr, "kernel_launch: memset of the barrier words failed\n"); return; }
    Params p{};
    for (int i = 0; i < 26; ++i) p.in[i] = (const float*)d_in[i];
    p.out = (float*)d_out; p.ws = (unsigned char*)d_ws; p.rep_ph = REP_PH; p.rep_n = REP_N;
#if N_LAUNCH_SPLIT
    for (int ph = 0; ph < NPHASE; ++ph) {
        p.ph_lo = ph; p.ph_hi = ph + 1;
        void* args[] = {&p};
        hipError_t e = hipLaunchCooperativeKernel((const void*)mega, dim3(grid), dim3(512), args, LDS_BYTES, stream);
        if (e != hipSuccess) { fprintf(stderr, "cooperative launch failed: %s (grid %d)\n", hipGetErrorString(e), grid); break; }
    }
#else
    p.ph_lo = 0; p.ph_hi = NPHASE;
    void* args[] = {&p};
    hipError_t e = hipLaunchCooperativeKernel((const void*)mega, dim3(grid), dim3(512), args, LDS_BYTES, stream);
    if (e != hipSuccess) fprintf(stderr, "cooperative launch failed: %s (grid %d)\n", hipGetErrorString(e), grid);
#endif
}
```
